# Optimizing an MI355X kernel written in HIP

```python
import jax, jax.numpy as jnp
from jax import lax
import numpy as np

D_MODEL = 1024
BATCH = 8
SEQ = 4096
DEPTH = 2

MLA_HEADS = 4
MLA_Q_RANK = 256
MLA_KV_RANK = 128
MLA_NOPE = 64
MLA_ROPE = 32
MLA_V = 64
MLA_Q_BLOCK = 128
SC_WIDTH = 256
SC_KERNEL = 3
CF_WIDTH = 256
CF_KERNEL = 31
GQ_HEADS = 4
GQ_KV_HEADS = 2
GQ_HEAD_DIM = 64
WINDOW = 128
BLOCK = 128
ROPE_THETA = 10000.0
N_EXPERTS = 16
EXPERT_FF = 1024
EC_CAPACITY_FACTOR = 2
LN_EPS = 1e-5
RMS_EPS = 1e-6
DEEPNORM_ALPHA = (2 * DEPTH) ** 0.25
DEEPNORM_BETA = (8 * DEPTH) ** -0.25
NEG_INF = -1e30

IN_SPLITS = (MLA_Q_RANK, MLA_KV_RANK, MLA_ROPE,
             SC_WIDTH, SC_WIDTH, SC_WIDTH,
             CF_WIDTH, CF_WIDTH,
             GQ_HEADS * GQ_HEAD_DIM, GQ_KV_HEADS * GQ_HEAD_DIM, GQ_KV_HEADS * GQ_HEAD_DIM)
D_IN = sum(IN_SPLITS)
D_MIX = MLA_HEADS * MLA_V + SC_WIDTH + CF_WIDTH + GQ_HEADS * GQ_HEAD_DIM

kernel_name = "hybrid_parallel_mla_conv_swa_ecmoe_encoder"


def layer_norm(x, g, b):
    xf = x.astype(jnp.float32)
    mu = jnp.mean(xf, axis=-1, keepdims=True)
    var = jnp.mean(jnp.square(xf - mu), axis=-1, keepdims=True)
    y = (xf - mu) * lax.rsqrt(var + LN_EPS) * g.astype(jnp.float32) + b.astype(jnp.float32)
    return y.astype(x.dtype)


def rms_norm(x, g):
    xf = x.astype(jnp.float32)
    y = xf * lax.rsqrt(jnp.mean(jnp.square(xf), axis=-1, keepdims=True) + RMS_EPS) * g.astype(jnp.float32)
    return y.astype(x.dtype)


def rope_cos_sin(positions, dim):
    inv = 1.0 / (ROPE_THETA ** (jnp.arange(0, dim, 2, dtype=jnp.float32) / dim))
    ang = positions.astype(jnp.float32)[..., None] * inv
    return jnp.cos(ang), jnp.sin(ang)


def apply_rope(x, cos, sin):
    xf = x.astype(jnp.float32)
    x1, x2 = jnp.split(xf, 2, axis=-1)
    c = cos[:, :, None, :]
    s = sin[:, :, None, :]
    return jnp.concatenate([x1 * c - x2 * s, x2 * c + x1 * s], axis=-1).astype(x.dtype)


def depthwise_conv(x, w):
    k = w.shape[0]
    c = x.shape[-1]
    return lax.conv_general_dilated(
        x, w[:, None, :].astype(x.dtype), window_strides=(1,),
        padding=[(k // 2, k // 2)], dimension_numbers=('NWC', 'WIO', 'NWC'),
        feature_group_count=c)


def mla_attention(q_lat, kv_lat, k_rope, q_norm_g, w_uq, kv_norm_g, w_ukv, cos, sin):
    b, s, _ = q_lat.shape
    h = MLA_HEADS
    dqk = MLA_NOPE + MLA_ROPE
    q = (rms_norm(q_lat, q_norm_g) @ w_uq).reshape(b, s, h, dqk)
    q = jnp.concatenate([q[..., :MLA_NOPE], apply_rope(q[..., MLA_NOPE:], cos, sin)], axis=-1)
    kv = (rms_norm(kv_lat, kv_norm_g) @ w_ukv).reshape(b, s, h, MLA_NOPE + MLA_V)
    k_nope, v = kv[..., :MLA_NOPE], kv[..., MLA_NOPE:]
    k_pe = apply_rope(k_rope[:, :, None, :], cos, sin)
    k = jnp.concatenate([k_nope, jnp.broadcast_to(k_pe, (b, s, h, MLA_ROPE))], axis=-1)
    scale = dqk ** -0.5
    nb = s // MLA_Q_BLOCK
    q_blocks = q.reshape(b, nb, MLA_Q_BLOCK, h, dqk).transpose(1, 0, 2, 3, 4)

    def attend(qb):
        sc = jnp.einsum('bqhd,bkhd->bhqk', qb, k).astype(jnp.float32) * scale
        p = jax.nn.softmax(sc, axis=-1).astype(v.dtype)
        return jnp.einsum('bhqk,bkhd->bqhd', p, v)

    o = lax.map(attend, q_blocks)
    return o.transpose(1, 0, 2, 3, 4).reshape(b, s, h * MLA_V)


def window_gqa(q, k, v, sink, cos, sin):
    b, s, _ = q.shape
    h, kvh, d = GQ_HEADS, GQ_KV_HEADS, GQ_HEAD_DIM
    g = h // kvh
    nb = s // BLOCK
    q = apply_rope(q.reshape(b, s, h, d), cos, sin).reshape(b, nb, BLOCK, kvh, g, d)
    k = apply_rope(k.reshape(b, s, kvh, d), cos, sin)
    v = v.reshape(b, s, kvh, d)
    pad = ((0, 0), (BLOCK, BLOCK), (0, 0), (0, 0))
    kp = jnp.pad(k, pad).reshape(b, nb + 2, BLOCK, kvh, d)
    vp = jnp.pad(v, pad).reshape(b, nb + 2, BLOCK, kvh, d)
    kb = jnp.concatenate([kp[:, :-2], kp[:, 1:-1], kp[:, 2:]], axis=2)
    vb = jnp.concatenate([vp[:, :-2], vp[:, 1:-1], vp[:, 2:]], axis=2)
    sc = jnp.einsum('bnqkgd,bnjkd->bnkgqj', q, kb).astype(jnp.float32) * (d ** -0.5)
    blk = jnp.arange(nb)[:, None]
    q_pos = blk * BLOCK + jnp.arange(BLOCK)[None, :]
    k_pos = (blk - 1) * BLOCK + jnp.arange(3 * BLOCK)[None, :]
    valid = ((jnp.abs(q_pos[:, :, None] - k_pos[:, None, :]) <= WINDOW)
             & (k_pos[:, None, :] >= 0) & (k_pos[:, None, :] < s))
    sc = jnp.where(valid[None, :, None, None], sc, NEG_INF)
    sink_l = jnp.broadcast_to(sink.astype(jnp.float32).reshape(kvh, g, 1, 1), sc.shape[:-1] + (1,))
    p = jax.nn.softmax(jnp.concatenate([sc, sink_l], axis=-1), axis=-1)[..., :-1].astype(v.dtype)
    o = jnp.einsum('bnkgqj,bnjkd->bnqkgd', p, vb)
    return o.reshape(b, s, h * d)


def conformer_conv(a, gate, w_dw, b_dw, g_n, b_n):
    u = a * jax.nn.sigmoid(gate)
    u = depthwise_conv(u, w_dw) + b_dw.astype(u.dtype)
    return jax.nn.silu(layer_norm(u, g_n, b_n))


def expert_choice_moe(x, w_router, b_router, w_gate, w_up, w_down):
    b, s, d = x.shape
    cap = EC_CAPACITY_FACTOR * s // N_EXPERTS
    logits = (x @ w_router).astype(jnp.float32) + b_router.astype(jnp.float32)
    aff = jax.nn.softmax(logits, axis=-1)
    gates, idx = lax.top_k(aff.transpose(0, 2, 1), cap)
    xs = jax.vmap(lambda xb, ib: xb[ib])(x, idx)
    hid = jax.nn.silu(jnp.einsum('becd,edf->becf', xs, w_gate)) * jnp.einsum('becd,edf->becf', xs, w_up)
    o = jnp.einsum('becf,efd->becd', hid, w_down) * gates[..., None].astype(x.dtype)
    y = jax.vmap(lambda ib, ob: jnp.zeros((s, d), ob.dtype).at[ib.reshape(-1)].add(ob.reshape(-1, d)))(idx, o)
    return y


def _normal(k, shape, scale):
    return jax.random.normal(k, shape, jnp.float32) * scale


def setup_inputs(seed: int = 0) -> dict:
    key = jax.random.key(seed)
    ks = jax.random.split(key, 24)
    L = DEPTH
    x = jax.random.normal(ks[0], (BATCH, SEQ, D_MODEL), jnp.float32)
    offset = jax.random.randint(ks[1], (BATCH, 1), 0, 1024, dtype=jnp.int32)
    positions = (offset + jnp.arange(SEQ, dtype=jnp.int32)[None, :]).astype(jnp.int32)
    return {
        "x": x,
        "positions": positions,
        "w_in": _normal(ks[2], (L, D_MODEL, D_IN), D_MODEL ** -0.5),
        "q_norm_g": 1.0 + _normal(ks[3], (L, MLA_Q_RANK), 0.02),
        "w_uq": _normal(ks[4], (L, MLA_Q_RANK, MLA_HEADS * (MLA_NOPE + MLA_ROPE)), MLA_Q_RANK ** -0.5),
        "kv_norm_g": 1.0 + _normal(ks[5], (L, MLA_KV_RANK), 0.02),
        "w_ukv": _normal(ks[6], (L, MLA_KV_RANK, MLA_HEADS * (MLA_NOPE + MLA_V)), MLA_KV_RANK ** -0.5),
        "sconv_w": _normal(ks[7], (L, SC_KERNEL, SC_WIDTH), SC_KERNEL ** -0.5),
        "cconv_w": _normal(ks[8], (L, CF_KERNEL, CF_WIDTH), CF_KERNEL ** -0.5),
        "cconv_b": _normal(ks[9], (L, CF_WIDTH), 0.02),
        "cnorm_g": 1.0 + _normal(ks[10], (L, CF_WIDTH), 0.02),
        "cnorm_b": _normal(ks[11], (L, CF_WIDTH), 0.02),
        "sink": _normal(ks[12], (L, GQ_HEADS), 0.5),
        "w_out": _normal(ks[13], (L, D_MIX, D_MODEL), DEEPNORM_BETA * D_MIX ** -0.5),
        "ln1_g": 1.0 + _normal(ks[14], (L, D_MODEL), 0.02),
        "ln1_b": _normal(ks[15], (L, D_MODEL), 0.02),
        "w_router": _normal(ks[16], (L, D_MODEL, N_EXPERTS), D_MODEL ** -0.5),
        "b_router": _normal(ks[17], (L, N_EXPERTS), 0.01),
        "w_gate": _normal(ks[18], (L, N_EXPERTS, D_MODEL, EXPERT_FF), D_MODEL ** -0.5),
        "w_up": _normal(ks[19], (L, N_EXPERTS, D_MODEL, EXPERT_FF), D_MODEL ** -0.5),
        "w_down": _normal(ks[20], (L, N_EXPERTS, EXPERT_FF, D_MODEL), DEEPNORM_BETA * EXPERT_FF ** -0.5),
        "ln2_g": 1.0 + _normal(ks[21], (L, D_MODEL), 0.02),
        "ln2_b": _normal(ks[22], (L, D_MODEL), 0.02),
    }


def reference(x, positions, w_in, q_norm_g, w_uq, kv_norm_g, w_ukv, sconv_w, cconv_w, cconv_b,
              cnorm_g, cnorm_b, sink, w_out, ln1_g, ln1_b, w_router, b_router, w_gate, w_up,
              w_down, ln2_g, ln2_b):
    cos_a, sin_a = rope_cos_sin(positions, MLA_ROPE)
    cos_d, sin_d = rope_cos_sin(positions, GQ_HEAD_DIM)
    split_points = np.cumsum(IN_SPLITS)[:-1].tolist()
    for l in range(DEPTH):
        proj = x @ w_in[l]
        (q_lat, kv_lat, k_rope, sc_b, sc_c, sc_h, cf_a, cf_g,
         gq_q, gq_k, gq_v) = jnp.split(proj, split_points, axis=-1)
        y_a = mla_attention(q_lat, kv_lat, k_rope, q_norm_g[l], w_uq[l], kv_norm_g[l], w_ukv[l], cos_a, sin_a)
        y_b = sc_b * depthwise_conv(sc_c * sc_h, sconv_w[l])
        y_c = conformer_conv(cf_a, cf_g, cconv_w[l], cconv_b[l], cnorm_g[l], cnorm_b[l])
        y_d = window_gqa(gq_q, gq_k, gq_v, sink[l], cos_d, sin_d)
        mix = jnp.concatenate([y_a, y_b, y_c, y_d], axis=-1) @ w_out[l]
        x = layer_norm(DEEPNORM_ALPHA * x + mix, ln1_g[l], ln1_b[l])
        moe = expert_choice_moe(x, w_router[l], b_router[l], w_gate[l], w_up[l], w_down[l])
        x = layer_norm(DEEPNORM_ALPHA * x + moe, ln2_g[l], ln2_b[l])
    return x
```

```cpp
#include <hip/hip_runtime.h>
#include <hip/hip_cooperative_groups.h>
#include <cstdio>
#include <cstdint>
namespace cg = cooperative_groups;


#define LAS __attribute__((address_space(3)))
typedef unsigned short bf16_t;
typedef short bf16x8 __attribute__((ext_vector_type(8)));
typedef short s16x4 __attribute__((ext_vector_type(4)));
typedef float f32x2 __attribute__((ext_vector_type(2)));
typedef float f32x4 __attribute__((ext_vector_type(4)));
typedef float f32x16 __attribute__((ext_vector_type(16)));
typedef unsigned u32x2 __attribute__((ext_vector_type(2)));
typedef unsigned u32x4 __attribute__((ext_vector_type(4)));
typedef __bf16 bf16x2_t __attribute__((ext_vector_type(2)));
typedef int v4i_t __attribute__((ext_vector_type(4)));
typedef int v8i_t __attribute__((ext_vector_type(8)));

constexpr int NB = 8, SEQ = 4096, DM = 1024, NTOK = NB * SEQ, DEPTH = 2;
constexpr int DIN = 2208, NPROJ = 2304;
constexpr int NE = 16, FF = 1024, CAP = 512, EROWS = NB * CAP;
constexpr float LN_EPS = 1e-5f, RMS_EPS = 1e-6f, ALPHA = 1.41421356237309515f;
constexpr float LOG2E = 1.4426950408889634f;
constexpr int PC_QLAT = 0, PC_KVLAT = 256, PC_KROPE = 384, PC_SCB = 512, PC_SCC = 768, PC_SCH = 1024, PC_CFA = 1280, PC_CFG = 1536, PC_GQQ = 1792, PC_GQK = 2048, PC_GQV = 2176;
constexpr int SC_QLAT = 0, SC_KVLAT = 256, SC_KROPE = 384, SC_SCB = 416, SC_SCC = 672, SC_SCH = 928, SC_CFA = 1184, SC_CFG = 1440, SC_GQQ = 1696, SC_GQK = 1952, SC_GQV = 2080;

constexpr size_t MiB = 1u << 20;
constexpr size_t WS_CTL = 0;
constexpr size_t WS_COSA = 1 * MiB, WS_SINA = 3 * MiB;
constexpr size_t WS_COSD = 5 * MiB, WS_SIND = 9 * MiB;
constexpr size_t WS_SSQQ = 13 * MiB, WS_SSQKV = 13 * MiB + 512 * 1024;
constexpr size_t WS_AFF = 14 * MiB;
constexpr size_t WS_SLOT = 17 * MiB;
constexpr size_t WS_WIN = 20 * MiB;
constexpr size_t WS_WUQ = 25 * MiB;
constexpr size_t WS_WUKV = 25 * MiB + 512 * 1024;
constexpr size_t WS_WOUT = 26 * MiB;
constexpr size_t WS_WGU = 28 * MiB;
constexpr size_t WS_XF8 = 60 * MiB;
constexpr size_t WS_MIXIN = 28 * MiB;
constexpr size_t WS_WD = 92 * MiB;
constexpr size_t WS_XBF = 124 * MiB;
constexpr size_t WS_R1 = 188 * MiB;
constexpr size_t WS_R2 = 332 * MiB;
constexpr size_t WS_QM = WS_R2, WS_KM = WS_R2 + 24 * MiB, WS_VTM = WS_R2 + 48 * MiB, WS_VTG = WS_R2 + 64 * MiB;
constexpr size_t WS_END = 460 * MiB;

constexpr int RING_BYTES = 131072;
constexpr int GIDX_OFF = 131072, GIDX_BYTES = 16384;
constexpr int LDS_BYTES = GIDX_OFF + GIDX_BYTES + 256;

__device__ __forceinline__ unsigned pk2(float lo, float hi) { f32x2 v = {lo, hi}; bf16x2_t b = __builtin_convertvector(v, bf16x2_t); return __builtin_bit_cast(unsigned, b); }
__device__ __forceinline__ bf16_t f2bf(float f) { return (bf16_t)(pk2(f, 0.f) & 0xffffu); }
__device__ __forceinline__ float bf2f(unsigned short h) { return __uint_as_float(((unsigned)h) << 16); }
__device__ __forceinline__ float bflo(unsigned w) { return __uint_as_float(w << 16); }
__device__ __forceinline__ float bfhi(unsigned w) { return __uint_as_float(w & 0xffff0000u); }
__device__ __forceinline__ float wave_sum(float v) {
    v += __int_as_float(__builtin_amdgcn_update_dpp(0, __float_as_int(v), 0xB1, 0xF, 0xF, true));
    v += __int_as_float(__builtin_amdgcn_update_dpp(0, __float_as_int(v), 0x4E, 0xF, 0xF, true));
    v += __int_as_float(__builtin_amdgcn_update_dpp(0, __float_as_int(v), 0x141, 0xF, 0xF, true));
    v += __int_as_float(__builtin_amdgcn_update_dpp(0, __float_as_int(v), 0x140, 0xF, 0xF, true));
    const float r0 = __int_as_float(__builtin_amdgcn_readlane(__float_as_int(v), 0)), r1 = __int_as_float(__builtin_amdgcn_readlane(__float_as_int(v), 16));
    const float r2 = __int_as_float(__builtin_amdgcn_readlane(__float_as_int(v), 32)), r3 = __int_as_float(__builtin_amdgcn_readlane(__float_as_int(v), 48));
    return (r0 + r1) + (r2 + r3);
}

__device__ __forceinline__ void unpack8(const u32x4 w, float* v) { v[0] = bflo(w[0]); v[1] = bfhi(w[0]); v[2] = bflo(w[1]); v[3] = bfhi(w[1]); v[4] = bflo(w[2]); v[5] = bfhi(w[2]); v[6] = bflo(w[3]); v[7] = bfhi(w[3]); }
__device__ __forceinline__ u32x4 pack8(const float* v) { return (u32x4){pk2(v[0], v[1]), pk2(v[2], v[3]), pk2(v[4], v[5]), pk2(v[6], v[7])}; }
__device__ __forceinline__ unsigned cvt4_fp8(const f32x4 v) { int w = __builtin_amdgcn_cvt_pk_fp8_f32(v[0], v[1], 0, false); return (unsigned)__builtin_amdgcn_cvt_pk_fp8_f32(v[2], v[3], w, true); }
__device__ __forceinline__ void acc16_fp8(const u32x4 w, float* v, float sc) {
#pragma unroll
    for (int q = 0; q < 4; ++q) { const f32x2 a = __builtin_amdgcn_cvt_pk_f32_fp8((int)w[q], false), b = __builtin_amdgcn_cvt_pk_f32_fp8((int)w[q], true);
        v[4 * q] += a[0] * sc; v[4 * q + 1] += a[1] * sc; v[4 * q + 2] += b[0] * sc; v[4 * q + 3] += b[1] * sc; }
}
__device__ __forceinline__ void ln_row16(float* v, const float* gg, const float* bb) {
    float s = 0.f;
#pragma unroll
    for (int i = 0; i < 16; ++i) s += v[i];
    const float mean = wave_sum(s) * (1.0f / DM); float s2 = 0.f;
#pragma unroll
    for (int i = 0; i < 16; ++i) { v[i] -= mean; s2 += v[i] * v[i]; }
    const float rstd = 1.0f / sqrtf(wave_sum(s2) * (1.0f / DM) + LN_EPS);
#pragma unroll
    for (int i = 0; i < 16; ++i) v[i] = v[i] * rstd * gg[i] + bb[i];
}
__device__ __forceinline__ float fast_sigmoid(float x) { return __builtin_amdgcn_rcpf(1.f + __expf(-x)); }

namespace pg8 {
constexpr int BM = 256, BK = 64, HALF = 128, HTB = HALF * BK * 2, STAGE_BYTES = 8 * HTB, NXCD = 8, WGM = 8;
__host__ __device__ __forceinline__ int lds_byte(int r, int c) { const int st = (r >> 4) * 2 + (c >> 5), rr = r & 15, cc = c & 31, ob = rr * 64 + cc * 2; return st * 1024 + (ob ^ (((ob >> 9) & 1) << 5)); }
__host__ __device__ __forceinline__ void stage_rc(int b, int& R, int& C) { const int st = b / 1024, sb = b % 1024, swz = sb ^ (((sb >> 9) & 1) << 5); R = (st >> 1) * 16 + swz / 64; C = (st & 1) * 32 + (swz % 64) / 2; }

struct Unit { int pm, pn, e; };
struct Gemm { const bf16_t* A; const bf16_t* Bt; int lda, ldb, K; long strideA, strideB; int sw = 0, sx = 0; };

struct Order {
    int nM, nN, nE, nwg, G, c;
    __device__ __forceinline__ void init(int M, int N, int E, int G_, int c_) { nM = M / BM; nN = N / BM; nE = E; nwg = nM * nN * nE; G = G_; c = c_; }
    __device__ __forceinline__ bool next(int i, Unit& u) const {
        const long L = (long)i * G + c; if (L >= nwg) return false;
        int wgid = (int)L; { const int q = nwg / NXCD, r = nwg % NXCD, xcd = wgid % NXCD, off = wgid / NXCD; wgid = (xcd < r ? xcd * (q + 1) : r * (q + 1) + (xcd - r) * q) + off; }
        const int per = nM * nN; u.e = wgid / per; const int w = wgid % per;
        const int nig = WGM * nN, gid = w / nig, fm = gid * WGM, gsz = (nM - fm) < WGM ? (nM - fm) : WGM;
        u.pm = fm + ((w % nig) % gsz); u.pn = (w % nig) / gsz; return true;
    }
};


struct PanelOrder {
    int e, pm, nN;
    __device__ __forceinline__ void init(int bx, int nN_) { const int xcd = bx & 7, j = bx >> 3; e = xcd * 2 + (j >> 4); pm = j & 15; nN = nN_; }
    __device__ __forceinline__ bool next(int i, Unit& u) const { if (i >= nN) return false; u.e = e; u.pm = pm; u.pn = i; return true; }
};

template <class Epi, bool GATHER, class Sched, int GSTRIDE = BM, bool FP8 = false>
__device__ __forceinline__ void gemm_phase(const int tid, LAS unsigned char* lds, const LAS int* gidx, const Gemm g, const Sched& S, const Epi& E) {
    const int wid = __builtin_amdgcn_readfirstlane(tid >> 6), lane = tid & 63, wr = wid >> 2, wc = wid & 3, fr = lane & 15, fq = lane >> 4;
    int nt = g.K / BK; asm volatile("" : "+s"(nt));
    int Rs[2], Cs[2]; unsigned voffB[2], voffA[2][2];
#pragma unroll
    for (int i = 0; i < 2; ++i) { int R, C; stage_rc(tid * 16 + i * 8192, R, C); Rs[i] = R; Cs[i] = C; voffB[i] = (unsigned)(R * g.ldb + C) * 2u; }
    const size_t kstep = (size_t)(BK * 2);
    const size_t hstepB = (size_t)HALF * g.ldb * 2;
    const unsigned ldsw = (unsigned)wid * 1024u;
    const int aoff = lds_byte(wr * 64 + fr, FP8 ? fq * 16 : fq * 8), boff = lds_byte(wc * 32 + fr, FP8 ? fq * 16 : fq * 8);
    constexpr int KFS = FP8 ? 16 : 1024;
#define PG8_SA(b, h) (((b) * 2 + (h)) * HTB)
#define PG8_SB(b, h) ((4 + (b) * 2 + (h)) * HTB)
#define PG8_STAGE(bufoff, gptr, v0, v1) do { \
        __builtin_amdgcn_global_load_lds((const unsigned*)((gptr) + (v0)), (LAS unsigned*)(lds + (bufoff) + ldsw), 16, 0, 0); \
        __builtin_amdgcn_global_load_lds((const unsigned*)((gptr) + (v1)), (LAS unsigned*)(lds + (bufoff) + ldsw + 8192), 16, 0, 0); } while (0)
#define PG8_STA(bufoff, gptr, V, h) PG8_STAGE(bufoff, gptr, V[h][0], V[h][1])
#define PG8_STB(bufoff, gptr, h) PG8_STAGE(bufoff, (gptr) + (h) * hstepB, voffB[0], voffB[1])
#define PG8_LDA(dst, b, h) do { _Pragma("unroll") for (int m = 0; m < 4; ++m) { if constexpr (FP8) dst##8[m] = *(const LAS v8i_t*)(lds + PG8_SA(b, h) + aoff + m * 2048); \
        else { _Pragma("unroll") for (int k = 0; k < 2; ++k) dst[m][k] = *(const LAS bf16x8*)(lds + PG8_SA(b, h) + aoff + m * 2048 + k * KFS); } } } while (0)
#define PG8_LDB(dst, b, h) do { _Pragma("unroll") for (int n = 0; n < 2; ++n) { if constexpr (FP8) dst##8[n] = *(const LAS v8i_t*)(lds + PG8_SB(b, h) + boff + n * 2048); \
        else { _Pragma("unroll") for (int k = 0; k < 2; ++k) dst[n][k] = *(const LAS bf16x8*)(lds + PG8_SB(b, h) + boff + n * 2048 + k * KFS); } } } while (0)
#define PG8_MMA(ai, bj, At, Bt) do { __builtin_amdgcn_s_setprio(1); _Pragma("unroll") for (int m = 0; m < 4; ++m) _Pragma("unroll") for (int n = 0; n < 2; ++n) { \
        if constexpr (FP8) { acc[ai][bj][m][n] = __builtin_amdgcn_mfma_scale_f32_16x16x128_f8f6f4(Bt##8[n], At##8[m], acc[ai][bj][m][n], 0, 0, 0, g.sw, 0, g.sx); } \
        else { _Pragma("unroll") for (int k = 0; k < 2; ++k) acc[ai][bj][m][n] = __builtin_amdgcn_mfma_f32_16x16x32_bf16(Bt[n][k], At[m][k], acc[ai][bj][m][n], 0, 0, 0); } } \
        __builtin_amdgcn_s_setprio(0); } while (0)
#define PG8_WAIT_V(n) asm volatile("s_waitcnt vmcnt(" #n ")" ::: "memory")
#define PG8_WAIT_L(n) asm volatile("s_waitcnt lgkmcnt(" #n ")" ::: "memory")
#define PG8_BAR __builtin_amdgcn_s_barrier()
#define PG8_SCHED __builtin_amdgcn_sched_barrier(0)
#define PG8_BASEA(u) (GATHER ? (const char*)g.A : (const char*)g.A + ((size_t)(u).e * g.strideA + (size_t)(u).pm * BM * g.lda) * 2)
#define PG8_BASEB(u) ((const char*)g.Bt + ((size_t)(u).e * g.strideB + (size_t)(u).pn * BM * g.ldb) * 2)
#define PG8_VOFF(V, uidx) do { _Pragma("unroll") for (int h = 0; h < 2; ++h) _Pragma("unroll") for (int i = 0; i < 2; ++i) { \
        const int rr_ = h * HALF + Rs[i]; const int arow_ = GATHER ? gidx[(uidx) * GSTRIDE + rr_] : rr_; V[h][i] = (unsigned)(arow_ * g.lda + Cs[i]) * 2u; } } while (0)
    Unit cur, nxt; int ui = 0;
    if (!S.next(0, cur)) return;
    f32x4 acc[2][2][4][2];
#pragma unroll
    for (int a = 0; a < 2; ++a)
#pragma unroll
        for (int b = 0; b < 2; ++b)
#pragma unroll
            for (int m = 0; m < 4; ++m)
#pragma unroll
                for (int n = 0; n < 2; ++n) acc[a][b][m][n] = (f32x4){0.f, 0.f, 0.f, 0.f};
    bf16x8 At[4][2], B0[2][2], B1[2][2];
    v8i_t At8[4], B08[2], B18[2];
    const char* cA = PG8_BASEA(cur); const char* cB = PG8_BASEB(cur);
    PG8_VOFF(voffA, 0);
    PG8_STB(PG8_SB(0, 0), cB, 0); PG8_STB(PG8_SB(0, 1), cB, 1); PG8_STA(PG8_SA(0, 0), cA, voffA, 0); PG8_STA(PG8_SA(0, 1), cA, voffA, 1);
    if (wr == 1) PG8_BAR;
    PG8_WAIT_V(2); PG8_BAR;
    PG8_STB(PG8_SB(1, 0), cB + kstep, 0); PG8_STA(PG8_SA(1, 0), cA + kstep, voffA, 0); PG8_STB(PG8_SB(1, 1), cB + kstep, 1);
    PG8_WAIT_V(6); PG8_BAR;
    for (;;) {
        const bool has_next = S.next(ui + 1, nxt);
        const char* nA = has_next ? PG8_BASEA(nxt) : cA; const char* nB = has_next ? PG8_BASEB(nxt) : cB;
#pragma unroll 1
        for (int t = 0; t < nt; t += 2) {
            const bool last = (t == nt - 2);
            const char* a1 = cA + (size_t)(t + 1) * kstep;
            const char* a2 = last ? nA : cA + (size_t)(t + 2) * kstep; const char* b2 = last ? nB : cB + (size_t)(t + 2) * kstep;
            const char* a3 = a2 + kstep; const char* b3 = b2 + kstep;
            PG8_LDB(B0, 0, 0); PG8_LDB(B1, 0, 1); PG8_SCHED; PG8_LDA(At, 0, 0); PG8_STA(PG8_SA(1, 1), a1, voffA, 1);
            PG8_WAIT_V(8); PG8_WAIT_L(0); PG8_BAR; PG8_MMA(0, 0, At, B0); PG8_MMA(0, 1, At, B1); PG8_BAR; PG8_SCHED;
            if constexpr (GATHER) { if (last && has_next) { PG8_VOFF(voffA, ui + 1); } }
            PG8_LDA(At, 0, 1); PG8_STB(PG8_SB(0, 0), b2, 0); PG8_STB(PG8_SB(0, 1), b2, 1); PG8_STA(PG8_SA(0, 0), a2, voffA, 0);
            PG8_WAIT_V(8); PG8_WAIT_L(0); PG8_BAR; PG8_MMA(1, 0, At, B0); PG8_MMA(1, 1, At, B1); PG8_BAR; PG8_SCHED;
            PG8_LDB(B0, 1, 0); PG8_LDB(B1, 1, 1); PG8_SCHED; PG8_LDA(At, 1, 0); PG8_STA(PG8_SA(0, 1), a2, voffA, 1);
            PG8_WAIT_V(8); PG8_WAIT_L(0); PG8_BAR; PG8_MMA(0, 0, At, B0); PG8_MMA(0, 1, At, B1); PG8_BAR; PG8_SCHED;
            PG8_LDA(At, 1, 1); PG8_STB(PG8_SB(1, 0), b3, 0); PG8_STB(PG8_SB(1, 1), b3, 1); PG8_STA(PG8_SA(1, 0), a3, voffA, 0);
            PG8_WAIT_V(8); PG8_WAIT_L(0); PG8_BAR; PG8_MMA(1, 0, At, B0); PG8_MMA(1, 1, At, B1); PG8_BAR; PG8_SCHED;
        }
        if (wr == 0) PG8_BAR;
        E(acc, cur, wr, wc, fr, fq);
        if (!has_next) break;
#pragma unroll
        for (int a = 0; a < 2; ++a)
#pragma unroll
            for (int b = 0; b < 2; ++b)
#pragma unroll
                for (int m = 0; m < 4; ++m)
#pragma unroll
                    for (int n = 0; n < 2; ++n) acc[a][b][m][n] = (f32x4){0.f, 0.f, 0.f, 0.f};
        cur = nxt; cA = nA; cB = nB; ++ui;
        if (wr == 1) PG8_BAR;
    }
    PG8_WAIT_V(0);
    PG8_BAR;
#undef PG8_SA
#undef PG8_SB
#undef PG8_STAGE
#undef PG8_STA
#undef PG8_STB
#undef PG8_LDA
#undef PG8_LDB
#undef PG8_MMA
#undef PG8_WAIT_V
#undef PG8_WAIT_L
#undef PG8_BAR
#undef PG8_SCHED
#undef PG8_BASEA
#undef PG8_BASEB
#undef PG8_VOFF
}
}

#define EPI_ROWS_BEGIN _Pragma("unroll") for (int ai = 0; ai < 2; ++ai) _Pragma("unroll") for (int m = 0; m < 4; ++m) { const int rt = ai * 128 + wr * 64 + m * 16 + fr; const int row = u.pm * 256 + rt; (void)rt;
#define EPI_ROWS_END asm volatile("" ::: "memory"); }

__host__ __device__ __forceinline__ int perm32(int p) { return ((p >> 2) & 3) * 8 + ((p >> 4) & 1) * 4 + (p & 3); }
__device__ __forceinline__ float dpp_qx1(float v) { return __int_as_float(__builtin_amdgcn_update_dpp(0, __float_as_int(v), 0xB1, 0xF, 0xF, true)); }
__device__ __forceinline__ float dpp_qx2(float v) { return __int_as_float(__builtin_amdgcn_update_dpp(0, __float_as_int(v), 0x4E, 0xF, 0xF, true)); }
__device__ __forceinline__ f32x4 quad_transpose(f32x4 a, int p) {
    const bool o1 = p & 1, o2 = p & 2;
    { const float r0 = dpp_qx1(o1 ? a[0] : a[1]), r1 = dpp_qx1(o1 ? a[2] : a[3]); if (o1) { a[0] = r0; a[2] = r1; } else { a[1] = r0; a[3] = r1; } }
    { const float q0 = dpp_qx2(o2 ? a[0] : a[2]), q1 = dpp_qx2(o2 ? a[1] : a[3]); if (o2) { a[0] = q0; a[1] = q1; } else { a[2] = q0; a[3] = q1; } }
    return a;
}
__device__ __forceinline__ int vperm64(int s) { const int k = s & 63; return (s & ~63) | (32 * ((k >> 2) & 1) + 16 * (k >> 5) + 4 * ((k >> 3) & 3) + (k & 3)); }
__device__ __forceinline__ int vperm16(int s) { const int k = s & 15; return (s & ~15) | ((k & 3) | ((k & 4) << 1) | ((k & 8) >> 1)); }

struct EpiProj {
    bf16_t* proj; float* ssq_q; float* ssq_kv; unsigned char* Km; bf16_t* Vtg;
    const float* cosA; const float* sinA; const float* cosD; const float* sinD;
    __device__ __forceinline__ void operator()(const f32x4 (&acc)[2][2][4][2], const pg8::Unit& u, int wr, int wc, int fr0, int fq0) const {
        int fr = fr0, fq = fq0; asm volatile("" : "+v"(fr), "+v"(fq));
        const int pn = u.pn;
        const bool rp = pn >= 7 || (pn == 1 && wc == 0);
        const float* ct = (pn == 1) ? cosA : cosD; const float* st = (pn == 1) ? sinA : sinD; const int rw = (pn == 1) ? 16 : 32, ro = (pn == 1) ? fq * 4 : (wc & 1) * 16 + fq * 4;
#pragma unroll
        for (int ai = 0; ai < 2; ++ai) {
        f32x4 rc[4], rs[4];
        if (rp) {
#pragma unroll
            for (int m = 0; m < 4; ++m) { const size_t rr = (size_t)(u.pm * 256 + ai * 128 + wr * 64 + m * 16 + fr) * rw + ro; rc[m] = *(const f32x4*)(ct + rr); rs[m] = *(const f32x4*)(st + rr); }
        }
#pragma unroll
        for (int m = 0; m < 4; ++m) { const int rt = ai * 128 + wr * 64 + m * 16 + fr; const int row = u.pm * 256 + rt; (void)rt;
            bf16_t* prow = proj + (size_t)row * NPROJ + pn * 256 + wc * 32 + fq * 4;
            bf16_t* prow8 = proj + (size_t)row * NPROJ + pn * 256 + wc * 32 + fq * 8;
            if (pn >= 3 && pn <= 6) {
                const f32x4 a0 = acc[ai][0][m][0], a1 = acc[ai][0][m][1], g0 = acc[ai][1][m][0], g1 = acc[ai][1][m][1];
                f32x4 o0, o1;
                if (pn <= 4) { o0 = a0 * g0; o1 = a1 * g1; }
                else {
#pragma unroll
                    for (int j = 0; j < 4; ++j) { o0[j] = a0[j] * fast_sigmoid(g0[j]); o1[j] = a1[j] * fast_sigmoid(g1[j]); } }
                *(u32x4*)(proj + (size_t)row * NPROJ + (pn <= 4 ? PC_SCC : PC_CFA) + ((pn - 3) & 1) * 128 + wc * 32 + fq * 8) = (u32x4){pk2(o0[0], o0[1]), pk2(o0[2], o0[3]), pk2(o1[0], o1[1]), pk2(o1[2], o1[3])};
            } else if (pn == 0 || pn == 2) {
                float s = 0.f;
#pragma unroll
                for (int bj = 0; bj < 2; ++bj) { const f32x4 v0 = acc[ai][bj][m][0], v1 = acc[ai][bj][m][1];
                    s += (v0[0] * v0[0] + v0[1] * v0[1] + v0[2] * v0[2] + v0[3] * v0[3]) + (v1[0] * v1[0] + v1[1] * v1[1] + v1[2] * v1[2] + v1[3] * v1[3]);
                    *(u32x4*)(prow8 + bj * 128) = (u32x4){pk2(v0[0], v0[1]), pk2(v0[2], v0[3]), pk2(v1[0], v1[1]), pk2(v1[2], v1[3])}; }
                if (pn == 0) { s += __shfl_xor(s, 16); s += __shfl_xor(s, 32); if (fq == 0) ssq_q[(size_t)row * 4 + wc] = s; }
            } else if (pn == 1) {
                float s = 0.f;
                { const f32x4 v0 = acc[ai][0][m][0], v1 = acc[ai][0][m][1];
                  s += (v0[0] * v0[0] + v0[1] * v0[1] + v0[2] * v0[2] + v0[3] * v0[3]) + (v1[0] * v1[0] + v1[1] * v1[1] + v1[2] * v1[2] + v1[3] * v1[3]);
                  *(u32x4*)(prow8) = (u32x4){pk2(v0[0], v0[1]), pk2(v0[2], v0[3]), pk2(v1[0], v1[1]), pk2(v1[2], v1[3])}; }
                s += __shfl_xor(s, 16); s += __shfl_xor(s, 32); if (fq == 0) ssq_kv[(size_t)row * 4 + wc] = s;
                if (wc == 0) {
                    const f32x4 x1 = acc[ai][1][m][0], x2 = acc[ai][1][m][1];
                    const f32x4 c = rc[m], sn = rs[m];
                    const f32x4 o1 = x1 * c - x2 * sn, o2 = x2 * c + x1 * sn;
                    const u32x2 w12 = {cvt4_fp8(o1), cvt4_fp8(o2)};
                    const int b = row / SEQ, s_ = row % SEQ;
#pragma unroll
                    for (int h = 0; h < 4; ++h) *(u32x2*)(Km + ((size_t)(b * 4 + h) * SEQ + s_) * 96 + 64 + fq * 8) = w12;
                }
            } else if (pn == 7) {
                const int w = wc & 1;
                const f32x4 c = rc[m], sn = rs[m]; (void)w;
                const float sc = 0.125f * LOG2E;
#pragma unroll
                for (int bj = 0; bj < 2; ++bj) { const f32x4 x1 = acc[ai][bj][m][0], x2 = acc[ai][bj][m][1];
                    const f32x4 o1 = (x1 * c - x2 * sn) * sc, o2 = (x2 * c + x1 * sn) * sc;
                    *(u32x4*)(prow8 + bj * 128) = (u32x4){pk2(o1[0], o1[1]), pk2(o1[2], o1[3]), pk2(o2[0], o2[1]), pk2(o2[2], o2[3])}; }
            } else {
                const int w = wc & 1;
                const f32x4 c = rc[m], sn = rs[m]; (void)w;
                { const f32x4 x1 = acc[ai][0][m][0], x2 = acc[ai][0][m][1];
                  const f32x4 o1 = x1 * c - x2 * sn, o2 = x2 * c + x1 * sn;
                  *(u32x4*)(prow8) = (u32x4){pk2(o1[0], o1[1]), pk2(o1[2], o1[3]), pk2(o2[0], o2[1]), pk2(o2[2], o2[3])}; }
                const int b = row / SEQ, s_ = row % SEQ, p = fr & 3, sg = vperm16(s_ - p);
#pragma unroll
                for (int n = 0; n < 2; ++n) { const f32x4 v = quad_transpose(acc[ai][1][m][n], p); const int cv = wc * 32 + n * 16 + fq * 4 + p; const int kvh = cv >> 6, d = cv & 63;
                    *(u32x2*)(Vtg + ((size_t)(b * 2 + kvh) * 64 + d) * SEQ + sg) = (u32x2){pk2(v[0], v[1]), pk2(v[2], v[3])}; }
            }
        asm volatile("" ::: "memory"); }
        }
    }
};

struct EpiQup {
    unsigned char* Qm; const float* ssq_q; const float* cosA; const float* sinA;
    __device__ __forceinline__ void operator()(const f32x4 (&acc)[2][2][4][2], const pg8::Unit& u, int wr, int wc, int fr0, int fq0) const {
        int fr = fr0, fq = fq0; asm volatile("" : "+v"(fr), "+v"(fq));
        f32x4 sqv[2][4];
#pragma unroll
        for (int ai = 0; ai < 2; ++ai)
#pragma unroll
            for (int m = 0; m < 4; ++m) sqv[ai][m] = *(const f32x4*)(ssq_q + (size_t)(u.pm * 256 + ai * 128 + wr * 64 + m * 16 + fr) * 4);
        EPI_ROWS_BEGIN
            const f32x4 sq = sqv[ai][m];
            const float rstd = 1.0f / sqrtf((sq[0] + sq[1] + sq[2] + sq[3]) * (1.0f / 256.0f) + RMS_EPS);
            const int b = row / SEQ, s_ = row % SEQ;
#pragma unroll
            for (int bj = 0; bj < 2; ++bj) {
                const int g0 = u.pn * 256 + bj * 128 + wc * 32;
                if (g0 < 384) {
                    const int h = g0 / 96, j0 = g0 % 96;
                    unsigned char* qp = Qm + ((size_t)(b * 4 + h) * SEQ + s_) * 96 + j0 + fq * 8;
                    f32x4 x1 = acc[ai][bj][m][0] * (rstd * 8.0f), x2 = acc[ai][bj][m][1] * (rstd * 8.0f);
                    if (j0 == 64) {
                        const f32x4 c = *(const f32x4*)(cosA + (size_t)row * 16 + fq * 4), sn = *(const f32x4*)(sinA + (size_t)row * 16 + fq * 4);
                        const f32x4 o1 = x1 * c - x2 * sn, o2 = x2 * c + x1 * sn; x1 = o1; x2 = o2;
                    }
                    *(u32x2*)qp = (u32x2){cvt4_fp8(x1), cvt4_fp8(x2)};
                }
            }
        EPI_ROWS_END
    }
};

struct EpiKVup {
    unsigned char* Km; unsigned char* Vtm; const float* ssq_kv;
    __device__ __forceinline__ void operator()(const f32x4 (&acc)[2][2][4][2], const pg8::Unit& u, int wr, int wc, int fr0, int fq0) const {
        int fr = fr0, fq = fq0; asm volatile("" : "+v"(fr), "+v"(fq));
        f32x4 sqv[2][4];
#pragma unroll
        for (int ai = 0; ai < 2; ++ai)
#pragma unroll
            for (int m = 0; m < 4; ++m) sqv[ai][m] = *(const f32x4*)(ssq_kv + (size_t)(u.pm * 256 + ai * 128 + wr * 64 + m * 16 + fr) * 4);
        EPI_ROWS_BEGIN
            const f32x4 sq = sqv[ai][m];
            const float rstd = 1.0f / sqrtf((sq[0] + sq[1] + sq[2] + sq[3]) * (1.0f / 128.0f) + RMS_EPS);
            const int b = row / SEQ, s_ = row % SEQ;
#pragma unroll
            for (int bj = 0; bj < 2; ++bj) {
                const int h = u.pn * 2 + bj;
                if (wc < 2) {
                    unsigned char* kp = Km + ((size_t)(b * 4 + h) * SEQ + s_) * 96 + wc * 32 + fq * 8;
                    *(u32x2*)kp = (u32x2){cvt4_fp8(acc[ai][bj][m][0] * rstd), cvt4_fp8(acc[ai][bj][m][1] * rstd)};
                } else {
                    const int p = fr & 3, sg = vperm64(s_ - p);
#pragma unroll
                    for (int n = 0; n < 2; ++n) { const f32x4 v = quad_transpose(acc[ai][bj][m][n] * rstd, p); const int d = (wc - 2) * 32 + n * 16 + fq * 4 + p;
                        *(unsigned*)(Vtm + ((size_t)(b * 4 + h) * 64 + d) * SEQ + sg) = cvt4_fp8(v); }
                }
            }
        EPI_ROWS_END
    }
};

struct EpiOut {
    bf16_t* xb;
    __device__ __forceinline__ void operator()(const f32x4 (&acc)[2][2][4][2], const pg8::Unit& u, int wr, int wc, int fr0, int fq0) const {
        int fr = fr0, fq = fq0; asm volatile("" : "+v"(fr), "+v"(fq));
        u32x4 xr[2][4][2];
#pragma unroll
        for (int ai = 0; ai < 2; ++ai)
#pragma unroll
            for (int m = 0; m < 4; ++m)
#pragma unroll
                for (int bj = 0; bj < 2; ++bj) xr[ai][m][bj] = *(const u32x4*)(xb + (size_t)(u.pm * 256 + ai * 128 + wr * 64 + m * 16 + fr) * DM + u.pn * 256 + wc * 32 + fq * 8 + bj * 128);
        EPI_ROWS_BEGIN
            bf16_t* xp = xb + (size_t)row * DM + u.pn * 256 + wc * 32 + fq * 8;
#pragma unroll
            for (int bj = 0; bj < 2; ++bj) { const u32x4 x4 = xr[ai][m][bj]; const f32x4 a0 = acc[ai][bj][m][0], a1 = acc[ai][bj][m][1];
                *(u32x4*)(xp + bj * 128) = (u32x4){pk2(bflo(x4[0]) * ALPHA + a0[0], bfhi(x4[0]) * ALPHA + a0[1]), pk2(bflo(x4[1]) * ALPHA + a0[2], bfhi(x4[1]) * ALPHA + a0[3]),
                                                   pk2(bflo(x4[2]) * ALPHA + a1[0], bfhi(x4[2]) * ALPHA + a1[1]), pk2(bflo(x4[3]) * ALPHA + a1[2], bfhi(x4[3]) * ALPHA + a1[3])}; }
        EPI_ROWS_END
    }
};

struct EpiGateUp {
    unsigned char* hid8;
    __device__ __forceinline__ void operator()(const f32x4 (&acc)[2][2][4][2], const pg8::Unit& u, int wr, int wc, int fr0, int fq0) const {
        int fr = fr0, fq = fq0; asm volatile("" : "+v"(fr), "+v"(fq));
        EPI_ROWS_BEGIN
            unsigned char* hp = hid8 + ((size_t)u.e * EROWS + row) * FF + u.pn * 128 + wc * 32 + fq * 8;
            f32x4 o4[2];
#pragma unroll
            for (int n = 0; n < 2; ++n) { const f32x4 g = acc[ai][0][m][n], up = acc[ai][1][m][n];
                f32x4 e, r;
#pragma unroll
                for (int j = 0; j < 4; ++j) e[j] = __builtin_amdgcn_exp2f(-g[j]);
                const f32x4 d = e + 1.0f;
#pragma unroll
                for (int j = 0; j < 4; ++j) r[j] = __builtin_amdgcn_rcpf(d[j]);
                o4[n] = (g * up) * r; }
            int w0 = __builtin_amdgcn_cvt_pk_fp8_f32(o4[0][0], o4[0][1], 0, false); w0 = __builtin_amdgcn_cvt_pk_fp8_f32(o4[0][2], o4[0][3], w0, true);
            int w1 = __builtin_amdgcn_cvt_pk_fp8_f32(o4[1][0], o4[1][1], 0, false); w1 = __builtin_amdgcn_cvt_pk_fp8_f32(o4[1][2], o4[1][3], w1, true);
            *(u32x2*)hp = (u32x2){(unsigned)w0, (unsigned)w1};
        EPI_ROWS_END
    }
};

struct EpiDown {
    unsigned char* slab8; const LAS float* gate_l;
    __device__ __forceinline__ void operator()(const f32x4 (&acc)[2][2][4][2], const pg8::Unit& u, int wr, int wc, int fr0, int fq0) const {
        int fr = fr0, fq = fq0; asm volatile("" : "+v"(fr), "+v"(fq));
        EPI_ROWS_BEGIN
            const float gt = gate_l[rt] * 64.0f;
            unsigned char* sp = slab8 + ((size_t)u.e * EROWS + row) * DM + (u.pn * 16 + wc * 4 + fq) * 16;
            unsigned w[4];
#pragma unroll
            for (int bj = 0; bj < 2; ++bj) { const f32x4 v0 = acc[ai][bj][m][0] * gt, v1 = acc[ai][bj][m][1] * gt;
                int a = __builtin_amdgcn_cvt_pk_fp8_f32(v0[0], v0[1], 0, false); a = __builtin_amdgcn_cvt_pk_fp8_f32(v0[2], v0[3], a, true);
                int b = __builtin_amdgcn_cvt_pk_fp8_f32(v1[0], v1[1], 0, false); b = __builtin_amdgcn_cvt_pk_fp8_f32(v1[2], v1[3], b, true);
                w[2 * bj] = (unsigned)a; w[2 * bj + 1] = (unsigned)b; }
            *(u32x4*)sp = (u32x4){w[0], w[1], w[2], w[3]};
        EPI_ROWS_END
    }
};

__device__ __forceinline__ int crow(int r, int hi) { return (r & 3) + 8 * (r >> 2) + 4 * hi; }

__device__ __forceinline__ float max3f(float a, float b, float c) { float r; asm("v_max3_f32 %0, %1, %2, %3" : "=v"(r) : "v"(a), "v"(b), "v"(c)); return r; }
#define SBAR() __builtin_amdgcn_sched_barrier(0)

template <int DK, bool WIN>
__device__ __forceinline__ void attn_unit(const int tid, LAS unsigned char* lds, const bf16_t* Qw, int qstride, const bf16_t* Kb, int kstride, const bf16_t* Vt,
                                          bf16_t* Ow, int ostride, int qpos0, int t_lo, int t_hi, float sink_l2) {
    constexpr int KROW = DK * 2, KT = 64 * KROW, VT = 8192, NS = DK / 16, NQK = 2 * NS, CPR = DK / 8, NKP = KT / 1024, NP = (NKP > 8 ? 2 : 1) + 1, VBASE = 3 * KT;
    constexpr float THR = 8.0f;
    const int lane = tid & 63, r32 = lane & 31, hi = lane >> 5, wid = __builtin_amdgcn_readfirstlane(tid >> 6);
    bf16x8 qr[NS];
#pragma unroll
    for (int s = 0; s < NS; ++s) qr[s] = *(const bf16x8*)(Qw + (size_t)r32 * qstride + s * 16 + hi * 8);
    const int kp0 = wid, kp1 = (wid + 8 < NKP) ? wid + 8 : wid;
    int koff0, koff1, voff;
    { const int L0 = kp0 * 64 + lane, r0 = L0 / CPR, c0 = L0 % CPR, f0 = (DK == 96) ? ((r0 >> 2) & 3) : ((r0 >> 1) & 7); koff0 = r0 * kstride + ((c0 ^ f0) * 8);
      const int L1 = kp1 * 64 + lane, r1 = L1 / CPR, c1 = L1 % CPR, f1 = (DK == 96) ? ((r1 >> 2) & 3) : ((r1 >> 1) & 7); koff1 = r1 * kstride + ((c1 ^ f1) * 8);
      const int Lv = wid * 64 + lane, dv = Lv >> 3, cv = Lv & 7; voff = dv * SEQ + ((cv ^ ((dv >> 1) & 7)) * 8); }
#define AT_DMA(tk, tv, sk, sv) do { const int tk_ = (tk) < t_hi ? (tk) : t_hi - 1, tv_ = (tv) < t_hi ? (tv) : t_hi - 1; \
        __builtin_amdgcn_global_load_lds((const unsigned*)(Kb + (size_t)tk_ * 64 * kstride + koff0), (LAS unsigned*)(lds + (sk) * KT + kp0 * 1024), 16, 0, 0); \
        if (NP == 3) __builtin_amdgcn_global_load_lds((const unsigned*)(Kb + (size_t)tk_ * 64 * kstride + koff1), (LAS unsigned*)(lds + (sk) * KT + kp1 * 1024), 16, 0, 0); \
        __builtin_amdgcn_global_load_lds((const unsigned*)(Vt + (size_t)tv_ * 64 + voff), (LAS unsigned*)(lds + VBASE + (sv) * VT + wid * 1024), 16, 0, 0); } while (0)
#define AT_WAITBAR(n) do { asm volatile("s_waitcnt vmcnt(%0)" :: "n"(n) : "memory"); __builtin_amdgcn_s_barrier(); asm volatile("" ::: "memory"); } while (0)
    int kaddr[NS], vaddr[4];
    { const int fk = (DK == 96) ? ((r32 >> 2) & 3) : ((r32 >> 1) & 7), fv = (r32 >> 1) & 7;
#pragma unroll
      for (int s = 0; s < NS; ++s) kaddr[s] = r32 * KROW + (((2 * s + hi) ^ fk) * 16);
#pragma unroll
      for (int q = 0; q < 4; ++q) vaddr[q] = VBASE + r32 * 128 + (((2 * q + hi) ^ fv) * 16); }
#define AT_LDK(ko, i) (*(const LAS bf16x8*)(lds + (ko) + (DK == 96 ? kaddr[((i) >> 1) & 1] + 64 * ((i) >> 2) : kaddr[(i) >> 1]) + ((i) & 1) * 32 * KROW))
#define AT_LDV(dst, vo, j) do { dst = *(const LAS bf16x8*)(lds + (vo) + vaddr[(j) >> 1] + ((j) & 1) * 32 * 128); } while (0)
#define AT_MASK(X0, X1, t) do { if (WIN) { const int qpos_ = qpos0 + r32, kbase_ = (t) * 64 + 4 * hi; \
        _Pragma("unroll") for (int r = 0; r < 16; ++r) { const int kp_ = kbase_ + (r & 3) + 8 * (r >> 2); int d0_ = qpos_ - kp_; d0_ = d0_ < 0 ? -d0_ : d0_; int d1_ = qpos_ - kp_ - 32; d1_ = d1_ < 0 ? -d1_ : d1_; \
            if (d0_ > 128) X0[r] = -INFINITY; if (d1_ > 128) X1[r] = -INFINITY; } } } while (0)
#define AT_HQ(X0, X1, h) do { if ((h) < 8) { X0[2 * ((h) & 7)] = __builtin_amdgcn_exp2f(X0[2 * ((h) & 7)]); X0[2 * ((h) & 7) + 1] = __builtin_amdgcn_exp2f(X0[2 * ((h) & 7) + 1]); pw[0][(h) & 7] = pk2(X0[2 * ((h) & 7)], X0[2 * ((h) & 7) + 1]); } \
        else { X1[2 * ((h) & 7)] = __builtin_amdgcn_exp2f(X1[2 * ((h) & 7)]); X1[2 * ((h) & 7) + 1] = __builtin_amdgcn_exp2f(X1[2 * ((h) & 7) + 1]); pw[1][(h) & 7] = pk2(X1[2 * ((h) & 7)], X1[2 * ((h) & 7) + 1]); } } while (0)
#define AT_PB(j) __builtin_bit_cast(bf16x8, (u32x4){pw[(j) >> 2][4 * (((j) >> 1) & 1)], pw[(j) >> 2][4 * (((j) >> 1) & 1) + 1], pw[(j) >> 2][4 * (((j) >> 1) & 1) + 2], pw[(j) >> 2][4 * (((j) >> 1) & 1) + 3]})
    float m_ref = 0.f, l_run = 0.f;
    f32x16 ot[2]; ot[0] = f32x16{}; ot[1] = f32x16{};
    f32x16 pA0, pA1, pB0, pB1;
    f32x16 negm;
    unsigned pw[2][8];
#define AT_REGION_A(X0, X1, N0, N1, ko, vo) do { bf16x8 kf[NQK]; kf[0] = AT_LDK(ko, 0); kf[1] = AT_LDK(ko, 1); kf[2] = AT_LDK(ko, 2); kf[3] = AT_LDK(ko, 3); \
        SBAR(); \
        _Pragma("unroll") for (int i = 0; i < NQK; ++i) { \
            if (i + 4 < NQK) kf[i + 4] = AT_LDK(ko, i + 4); else AT_LDV(vf[i + 4 - NQK], vo, i + 4 - NQK); \
            if ((i & 1) == 0) N0 = __builtin_amdgcn_mfma_f32_32x32x16_bf16(kf[i], qr[i >> 1], i < 2 ? negm : N0, 0, 0, 0); \
            else N1 = __builtin_amdgcn_mfma_f32_32x32x16_bf16(kf[i], qr[i >> 1], i < 2 ? negm : N1, 0, 0, 0); \
            if (i < 16 - NQK) { AT_HQ(X0, X1, 2 * i); AT_HQ(X0, X1, 2 * i + 1); } else { AT_HQ(X0, X1, i + 16 - NQK); } \
            SBAR(); } } while (0)
#define AT_REGION_B(X0, X1, N0, N1, vo, DOMAX) do { \
        float sa_ = 0.f, sb_ = 0.f, sc_ = 0.f, sd_ = 0.f; \
        _Pragma("unroll") for (int j = 0; j < 8; ++j) { \
            if (j + 4 < 8) AT_LDV(vf[j + 4], vo, j + 4); \
            ot[j & 1] = __builtin_amdgcn_mfma_f32_32x32x16_bf16(vf[j], AT_PB(j), ot[j & 1], 0, 0, 0); \
            if (j < 4) { sa_ += X0[4 * j]; sb_ += X0[4 * j + 1]; sc_ += X0[4 * j + 2]; sd_ += X0[4 * j + 3]; } else { sa_ += X1[4 * (j - 4)]; sb_ += X1[4 * (j - 4) + 1]; sc_ += X1[4 * (j - 4) + 2]; sd_ += X1[4 * (j - 4) + 3]; } \
            if (DOMAX && !WIN) { if (j == 2) { mxa = max3f(N0[0], N0[1], N1[0]); mxb = max3f(N0[2], N0[3], N1[1]); mxa = max3f(mxa, N1[2], N1[3]); } \
                if (j == 3) { mxa = max3f(mxa, N0[4], N0[5]); mxb = max3f(mxb, N0[6], N0[7]); mxa = max3f(mxa, N1[4], N1[5]); } \
                if (j == 4) { mxb = max3f(mxb, N1[6], N1[7]); mxa = max3f(mxa, N0[8], N0[9]); mxb = max3f(mxb, N0[10], N0[11]); } \
                if (j == 5) { mxa = max3f(mxa, N1[8], N1[9]); mxb = max3f(mxb, N1[10], N1[11]); mxa = max3f(mxa, N0[12], N0[13]); } \
                if (j == 6) { mxb = max3f(mxb, N0[14], N0[15]); mxa = max3f(mxa, N1[12], N1[13]); } \
                if (j == 7) { mxb = max3f(mxb, N1[14], N1[15]); } } \
            SBAR(); } \
        l_run += (sa_ + sb_) + (sc_ + sd_); } while (0)
#define AT_ROWMAX_ALL(X0, X1) do { mxa = max3f(X0[0], X0[1], X1[0]); mxb = max3f(X0[2], X0[3], X1[1]); mxa = max3f(mxa, X1[2], X1[3]); \
        _Pragma("unroll") for (int r = 4; r < 16; r += 4) { mxa = max3f(mxa, X0[r], X0[r + 1]); mxb = max3f(mxb, X0[r + 2], X0[r + 3]); mxa = max3f(mxa, X1[r], X1[r + 1]); mxb = max3f(mxb, X1[r + 2], X1[r + 3]); } } while (0)
#define AT_RM_FINISH(rm) do { rm = fmaxf(mxa, mxb); auto rr_ = __builtin_amdgcn_permlane32_swap(__float_as_uint(rm), __float_as_uint(rm), false, false); rm = fmaxf(__uint_as_float(rr_[0]), __uint_as_float(rr_[1])); } while (0)
#define AT_ROT() do { const int t_ = s0; s0 = s1; s1 = s2; s2 = t_; } while (0)
#define AT_BODY(X0, X1, N0, N1, T) do { float mxa = 0.f, mxb = 0.f, rm_; bf16x8 vf[8]; \
        AT_DMA((T) + 3, (T) + 2, s0, s2); \
        AT_REGION_A(X0, X1, N0, N1, s1 * KT, s0 * VT); \
        AT_REGION_B(X0, X1, N0, N1, s0 * VT, true); \
        if (WIN) { AT_MASK(N0, N1, (T) + 1); AT_ROWMAX_ALL(N0, N1); } \
        AT_RM_FINISH(rm_); \
        if (__any(rm_ > THR)) { const float dl_ = fmaxf(rm_, 0.f); m_ref += dl_; const float f_ = __builtin_amdgcn_exp2f(-dl_); l_run *= f_; \
            _Pragma("unroll") for (int r = 0; r < 16; ++r) { N0[r] -= dl_; N1[r] -= dl_; ot[0][r] *= f_; ot[1][r] *= f_; negm[r] = -m_ref; } } \
        AT_WAITBAR(NP); AT_ROT(); } while (0)
    int s0 = 0, s1 = 1, s2 = 2;
    AT_DMA(t_lo, t_lo, 0, 0); AT_DMA(t_lo + 1, t_lo + 1, 1, 1); AT_DMA(t_lo + 2, t_lo + 2, 2, 2);
    AT_WAITBAR(2 * NP);
    {
#pragma unroll
        for (int i = 0; i < NQK; ++i) { const bf16x8 kf = AT_LDK(0, i);
            if ((i & 1) == 0) pA0 = __builtin_amdgcn_mfma_f32_32x32x16_bf16(kf, qr[i >> 1], i < 2 ? f32x16{} : pA0, 0, 0, 0);
            else pA1 = __builtin_amdgcn_mfma_f32_32x32x16_bf16(kf, qr[i >> 1], i < 2 ? f32x16{} : pA1, 0, 0, 0); }
        asm volatile("s_nop 7\n\ts_nop 7" : "+v"(pA0), "+v"(pA1));
        AT_MASK(pA0, pA1, t_lo);
        float mxa, mxb, rm; AT_ROWMAX_ALL(pA0, pA1); AT_RM_FINISH(rm);
        const float ref = (rm == -INFINITY) ? 0.f : rm; m_ref = ref;
#pragma unroll
        for (int r = 0; r < 16; ++r) { pA0[r] -= ref; pA1[r] -= ref; negm[r] = -ref; }
    }
    AT_WAITBAR(NP);
    int t = t_lo;
    for (; t + 2 < t_hi; t += 2) { AT_BODY(pA0, pA1, pB0, pB1, t); AT_BODY(pB0, pB1, pA0, pA1, t + 1); }
    AT_BODY(pA0, pA1, pB0, pB1, t);
    {
        float mxa = 0.f, mxb = 0.f; (void)mxa; (void)mxb; bf16x8 vf[8];
        AT_LDV(vf[0], s0 * VT, 0); AT_LDV(vf[1], s0 * VT, 1); AT_LDV(vf[2], s0 * VT, 2); AT_LDV(vf[3], s0 * VT, 3);
#pragma unroll
        for (int h = 0; h < 16; ++h) AT_HQ(pB0, pB1, h);
        AT_REGION_B(pB0, pB1, pA0, pA1, s0 * VT, false);
        AT_WAITBAR(0);
    }
#undef AT_DMA
#undef AT_WAITBAR
#undef AT_LDK
#undef AT_LDV
#undef AT_MASK
#undef AT_HQ
#undef AT_PB
#undef AT_REGION_A
#undef AT_REGION_B
#undef AT_ROWMAX_ALL
#undef AT_RM_FINISH
#undef AT_ROT
#undef AT_BODY
    { auto rr = __builtin_amdgcn_permlane32_swap(__float_as_uint(l_run), __float_as_uint(l_run), false, false); l_run = __uint_as_float(rr[0]) + __uint_as_float(rr[1]); }
    if (WIN) l_run += __builtin_amdgcn_exp2f(sink_l2 - m_ref);
    const float inv = 1.0f / l_run;
    int lane2 = lane; asm volatile("" : "+v"(lane2));
    bf16_t* op = Ow + (size_t)(lane2 & 31) * ostride + 4 * (lane2 >> 5);
#pragma unroll
    for (int db = 0; db < 2; ++db)
#pragma unroll
        for (int g = 0; g < 4; ++g)
            *(u32x2*)(op + db * 32 + 8 * g) = (u32x2){pk2(ot[db][4 * g] * inv, ot[db][4 * g + 1] * inv), pk2(ot[db][4 * g + 2] * inv, ot[db][4 * g + 3] * inv)};
}

__device__ __forceinline__ v8i_t mk8(const u32x4 a, const u32x4 b) { return (v8i_t){(int)a[0], (int)a[1], (int)a[2], (int)a[3], (int)b[0], (int)b[1], (int)b[2], (int)b[3]}; }
#define F8_MMA(A, B, C, SB) __builtin_amdgcn_mfma_scale_f32_32x32x64_f8f6f4(A, B, C, 0, 0, 0, 0x7F7F7F7F, 0, SB)

__device__ __forceinline__ void attn_mla_f8(const int tid, LAS unsigned char* lds, const unsigned char* Qw, const unsigned char* Kb, const unsigned char* Vt, bf16_t* Ow, int ostride) {
    constexpr int KT = 6144, VT = 4096, VBASE = 3 * KT, NT = SEQ / 64, NP = 2;
    constexpr float THR = 8.0f, BIAS = 5.0f;
    constexpr int SQ = 0x7C7C7C7C;
    const int lane = tid & 63, r32 = lane & 31, hi = lane >> 5, wid = __builtin_amdgcn_readfirstlane(tid >> 6);
    v8i_t q0, q1;
    { const unsigned char* qp = Qw + (size_t)r32 * 96;
      q0 = mk8(*(const u32x4*)(qp + 32 * hi), *(const u32x4*)(qp + 32 * hi + 16));
      const u32x4 c = *(const u32x4*)(qp + 64), d = *(const u32x4*)(qp + 80); q1 = mk8(c, d); if (hi) q1 = (v8i_t){0, 0, 0, 0, 0, 0, 0, 0}; }
    const bool aK = wid < 6, bV = wid < 2;
    const unsigned char* pa; const unsigned char* pb;
    { const int L = wid * 64 + lane, row = L / 6, c = L % 6; const int ok = row * 96 + ((c ^ ((row >> 3) & 1)) * 16);
      const int Lv = (aK ? 0 : wid - 6) * 64 + lane, dv = Lv >> 2, cv = Lv & 3; const int ov = dv * SEQ + ((cv ^ ((dv >> 2) & 3)) * 16);
      const int Lw = (wid + 2) * 64 + lane, dw = (Lw >> 2) & 63, cw = Lw & 3; const int ow = dw * SEQ + ((cw ^ ((dw >> 2) & 3)) * 16);
      pa = aK ? Kb + ok : Vt + ov; pb = bV ? Vt + ow : pa; }
    const int dstA0 = aK ? wid * 1024 : VBASE + (wid - 6) * 1024, dstB0 = bV ? VBASE + (wid + 2) * 1024 : dstA0;
    const int stepA = aK ? KT : VT, stepB = bV ? VT : stepA;
    const int incA = aK ? KT : 64, incB = bV ? 64 : incA;
#define F8_DMA(tk, tv, sk, sv) do { \
        __builtin_amdgcn_global_load_lds((const unsigned*)pa, (LAS unsigned*)(lds + dstA0 + (aK ? (sk) : (sv)) * stepA), 16, 0, 0); \
        __builtin_amdgcn_global_load_lds((const unsigned*)pb, (LAS unsigned*)(lds + dstB0 + (bV ? (sv) : (aK ? (sk) : (sv))) * stepB), 16, 0, 0); \
        pa += incA; pb += incB; } while (0)
#define F8_WAITBAR(n) do { asm volatile("s_waitcnt vmcnt(%0) lgkmcnt(0)" :: "n"(n) : "memory"); __builtin_amdgcn_s_barrier(); asm volatile("" ::: "memory"); } while (0)
    const int fk = (r32 >> 3) & 1, fv = (r32 >> 2) & 3;
    const int ka0 = r32 * 96 + (((2 * hi) ^ fk) * 16), ka1 = r32 * 96 + ((4 ^ fk) * 16), va0 = VBASE + r32 * 64 + (((2 * hi) ^ fv) * 16);
#define F8_LDK(ko, kb, c) mk8(*(const LAS u32x4*)(lds + (ko) + ((c) ? ka1 : ka0) + (kb) * 3072), *(const LAS u32x4*)(lds + (ko) + (((c) ? ka1 : ka0) ^ 16) + (kb) * 3072))
#define F8_LDV(vo, db) mk8(*(const LAS u32x4*)(lds + (vo) + va0 + (db) * 2048), *(const LAS u32x4*)(lds + (vo) + (va0 ^ 16) + (db) * 2048))
#define F8_HQ(X0, X1, h) do { if ((h) < 8) { X0[2 * (h)] = __builtin_amdgcn_exp2f(X0[2 * (h)]); X0[2 * (h) + 1] = __builtin_amdgcn_exp2f(X0[2 * (h) + 1]); \
            pw[(h) >> 1] = __builtin_amdgcn_cvt_pk_fp8_f32(X0[2 * (h)], X0[2 * (h) + 1], pw[(h) >> 1], ((h) & 1) != 0); } \
        else { X1[2 * ((h) - 8)] = __builtin_amdgcn_exp2f(X1[2 * ((h) - 8)]); X1[2 * ((h) - 8) + 1] = __builtin_amdgcn_exp2f(X1[2 * ((h) - 8) + 1]); \
            pw[4 + (((h) - 8) >> 1)] = __builtin_amdgcn_cvt_pk_fp8_f32(X1[2 * ((h) - 8)], X1[2 * ((h) - 8) + 1], pw[4 + (((h) - 8) >> 1)], ((h) & 1) != 0); } } while (0)
    float m_ref = 0.f;
    f32x16 ot0 = f32x16{}, ot1 = f32x16{}, lacc = f32x16{};
    f32x16 pA0, pA1, pB0, pB1, negm;
    int pw[8] = {0, 0, 0, 0, 0, 0, 0, 0};
    const v8i_t ones8 = {0x38383838, 0x38383838, 0x38383838, 0x38383838, 0x38383838, 0x38383838, 0x38383838, 0x38383838};
#define F8_PIN(V) asm volatile("" : "+v"(V))
#define F8_REGION_A(X0, X1, N0, N1, vo) do { \
        SBAR(); \
        N0 = F8_MMA(kf00, q0, negm, SQ); F8_PIN(N0); F8_HQ(X0, X1, 0); F8_HQ(X0, X1, 1); F8_HQ(X0, X1, 2); F8_HQ(X0, X1, 3); SBAR(); \
        N1 = F8_MMA(kf10, q0, negm, SQ); F8_PIN(N1); vf0 = F8_LDV(vo, 0); F8_HQ(X0, X1, 4); F8_HQ(X0, X1, 5); F8_HQ(X0, X1, 6); F8_HQ(X0, X1, 7); SBAR(); \
        N0 = F8_MMA(kf01, q1, N0, SQ); F8_PIN(N0); vf1 = F8_LDV(vo, 1); F8_HQ(X0, X1, 8); F8_HQ(X0, X1, 9); F8_HQ(X0, X1, 10); F8_HQ(X0, X1, 11); SBAR(); \
        N1 = F8_MMA(kf11, q1, N1, SQ); F8_PIN(N1); F8_HQ(X0, X1, 12); F8_HQ(X0, X1, 13); F8_HQ(X0, X1, 14); F8_HQ(X0, X1, 15); SBAR(); } while (0)
#define F8_REGION_B(X0, X1, N0, N1, DOMAX, kn) do { const v8i_t pb_ = (v8i_t){pw[0], pw[1], pw[2], pw[3], pw[4], pw[5], pw[6], pw[7]}; \
        ot0 = F8_MMA(vf0, pb_, ot0, 0x7F7F7F7F); F8_PIN(ot0); \
        kf00 = F8_LDK(kn, 0, 0); kf10 = F8_LDK(kn, 1, 0); \
        if (DOMAX) { mxa = fmaxf(fmaxf(N0[0], N0[1]), N1[0]); mxb = fmaxf(fmaxf(N0[2], N0[3]), N1[1]); mxa = fmaxf(fmaxf(mxa, N1[2]), N1[3]); \
            _Pragma("unroll") for (int r = 4; r < 8; r += 4) { mxa = fmaxf(fmaxf(mxa, N0[r]), N0[r + 1]); mxb = fmaxf(fmaxf(mxb, N0[r + 2]), N0[r + 3]); mxa = fmaxf(fmaxf(mxa, N1[r]), N1[r + 1]); mxb = fmaxf(fmaxf(mxb, N1[r + 2]), N1[r + 3]); } \
            asm volatile("" : "+v"(mxa), "+v"(mxb)); } \
        SBAR(); \
        ot1 = F8_MMA(vf1, pb_, ot1, 0x7F7F7F7F); F8_PIN(ot1); \
        kf01 = F8_LDK(kn, 0, 1); kf11 = F8_LDK(kn, 1, 1); \
        if (DOMAX) { \
            _Pragma("unroll") for (int r = 8; r < 16; r += 4) { mxa = fmaxf(fmaxf(mxa, N0[r]), N0[r + 1]); mxb = fmaxf(fmaxf(mxb, N0[r + 2]), N0[r + 3]); mxa = fmaxf(fmaxf(mxa, N1[r]), N1[r + 1]); mxb = fmaxf(fmaxf(mxb, N1[r + 2]), N1[r + 3]); } \
            asm volatile("" : "+v"(mxa), "+v"(mxb)); } \
        SBAR(); \
        lacc = F8_MMA(ones8, pb_, lacc, 0x7F7F7F7F); F8_PIN(lacc); } while (0)
#define F8_RM_FINISH(rm) do { rm = fmaxf(mxa, mxb); auto rr_ = __builtin_amdgcn_permlane32_swap(__float_as_uint(rm), __float_as_uint(rm), false, false); rm = fmaxf(__uint_as_float(rr_[0]), __uint_as_float(rr_[1])); } while (0)
#define F8_ROT() do { const int t_ = s0; s0 = s1; s1 = s2; s2 = t_; } while (0)
#define F8_BODY(X0, X1, N0, N1, T) do { float mxa = 0.f, mxb = 0.f, rm_; v8i_t vf0, vf1; \
        F8_DMA(0, 0, s1, s2); \
        F8_REGION_A(X0, X1, N0, N1, s0 * VT); \
        F8_REGION_B(X0, X1, N0, N1, true, s2 * KT); \
        F8_RM_FINISH(rm_); \
        if (__any(rm_ > THR)) { const float dl_ = fmaxf(rm_ - BIAS, 0.f); m_ref += dl_; const float f_ = __builtin_amdgcn_exp2f(-dl_); \
            _Pragma("unroll") for (int r = 0; r < 16; ++r) { N0[r] -= dl_; N1[r] -= dl_; ot0[r] *= f_; ot1[r] *= f_; lacc[r] *= f_; negm[r] = -m_ref; } } \
        F8_WAITBAR(NP); F8_ROT(); } while (0)
    int s0 = 0, s1 = 1, s2 = 2;
    v8i_t kf00, kf10, kf01, kf11;
    F8_DMA(0, 0, 0, 0); F8_DMA(1, 1, 1, 1); F8_DMA(2, 2, 2, 2);
    pa -= (aK ? 0 : 64); pb -= (bV ? 64 : (aK ? 0 : 64));
    F8_WAITBAR(2 * NP);
    {
        const v8i_t k00 = F8_LDK(0, 0, 0), k10 = F8_LDK(0, 1, 0), k01 = F8_LDK(0, 0, 1), k11 = F8_LDK(0, 1, 1);
        pA0 = F8_MMA(k00, q0, f32x16{}, SQ); pA1 = F8_MMA(k10, q0, f32x16{}, SQ); pA0 = F8_MMA(k01, q1, pA0, SQ); pA1 = F8_MMA(k11, q1, pA1, SQ);
        float mxa, mxb, rm;
        mxa = fmaxf(fmaxf(pA0[0], pA0[1]), pA1[0]); mxb = fmaxf(fmaxf(pA0[2], pA0[3]), pA1[1]); mxa = fmaxf(fmaxf(mxa, pA1[2]), pA1[3]);
#pragma unroll
        for (int r = 4; r < 16; r += 4) { mxa = fmaxf(fmaxf(mxa, pA0[r]), pA0[r + 1]); mxb = fmaxf(fmaxf(mxb, pA0[r + 2]), pA0[r + 3]); mxa = fmaxf(fmaxf(mxa, pA1[r]), pA1[r + 1]); mxb = fmaxf(fmaxf(mxb, pA1[r + 2]), pA1[r + 3]); }
        F8_RM_FINISH(rm);
        const float ref = rm - BIAS; m_ref = ref;
#pragma unroll
        for (int r = 0; r < 16; ++r) { pA0[r] -= ref; pA1[r] -= ref; negm[r] = -ref; }
    }
    F8_WAITBAR(NP);
    F8_DMA(0, 0, 0, 2);
    pa -= (aK ? 0 : 64); pb -= (bV ? 64 : (aK ? 0 : 64));
    kf00 = F8_LDK(KT, 0, 0); kf10 = F8_LDK(KT, 1, 0); kf01 = F8_LDK(KT, 0, 1); kf11 = F8_LDK(KT, 1, 1);
    F8_WAITBAR(NP);
    int t = 0;
    for (; t + 2 < NT; t += 2) { F8_BODY(pA0, pA1, pB0, pB1, t); F8_BODY(pB0, pB1, pA0, pA1, t + 1); }
    F8_BODY(pA0, pA1, pB0, pB1, t);
    {
        float mxa = 0.f, mxb = 0.f; (void)mxa; (void)mxb;
        const v8i_t vf0 = F8_LDV(s0 * VT, 0), vf1 = F8_LDV(s0 * VT, 1);
        F8_HQ(pB0, pB1, 0); F8_HQ(pB0, pB1, 1); F8_HQ(pB0, pB1, 2); F8_HQ(pB0, pB1, 3); F8_HQ(pB0, pB1, 4); F8_HQ(pB0, pB1, 5); F8_HQ(pB0, pB1, 6); F8_HQ(pB0, pB1, 7); F8_HQ(pB0, pB1, 8); F8_HQ(pB0, pB1, 9); F8_HQ(pB0, pB1, 10); F8_HQ(pB0, pB1, 11); F8_HQ(pB0, pB1, 12); F8_HQ(pB0, pB1, 13); F8_HQ(pB0, pB1, 14); F8_HQ(pB0, pB1, 15);
        F8_REGION_B(pB0, pB1, pA0, pA1, false, s2 * KT);
        F8_WAITBAR(0);
    }
#undef F8_DMA
#undef F8_WAITBAR
#undef F8_LDK
#undef F8_LDV
#undef F8_HQ
#undef F8_REGION_A
#undef F8_PIN
#undef F8_REGION_B
#undef F8_RM_FINISH
#undef F8_ROT
#undef F8_BODY
    const float inv = 1.0f / lacc[0];
    int lane2 = lane; asm volatile("" : "+v"(lane2));
    bf16_t* op = Ow + (size_t)(lane2 & 31) * ostride + 4 * (lane2 >> 5);
#pragma unroll
    for (int g = 0; g < 4; ++g) {
        *(u32x2*)(op + 8 * g) = (u32x2){pk2(ot0[4 * g] * inv, ot0[4 * g + 1] * inv), pk2(ot0[4 * g + 2] * inv, ot0[4 * g + 3] * inv)};
        *(u32x2*)(op + 32 + 8 * g) = (u32x2){pk2(ot1[4 * g] * inv, ot1[4 * g + 1] * inv), pk2(ot1[4 * g + 2] * inv, ot1[4 * g + 3] * inv)}; }
}

__device__ __forceinline__ void conv_unit(const int tid, LAS unsigned char* lds, const bf16_t* proj, bf16_t* mixin, int tile,
                                          const float* sconv_w, const float* cconv_w, const float* cconv_b, const float* cnorm_g, const float* cnorm_b) {
    const int lane = tid & 63, wave = tid >> 6;
    const int t0 = tile * 64;
    const int s0 = t0 % SEQ;
    LAS bf16_t* ul = (LAS bf16_t*)lds;
    LAS float* vl = (LAS float*)(lds + 94 * 256 * 2);
    {
        u32x4 av[6];
#pragma unroll
        for (int q = 0; q < 6; ++q) { const int it = tid + q * 512; const int r = it >> 5, ch = (it & 31) * 8; const int sp = s0 - 15 + r;
            av[q] = (u32x4){0, 0, 0, 0};
            if (it < 94 * 32 && sp >= 0 && sp < SEQ) av[q] = *(const u32x4*)(proj + (size_t)(t0 - 15 + r) * NPROJ + PC_CFA + ch); }
#pragma unroll
        for (int q = 0; q < 6; ++q) { const int it = tid + q * 512; const int r = it >> 5, ch = (it & 31) * 8;
            if (it < 94 * 32) *(LAS u32x4*)(ul + r * 256 + ch) = av[q]; }
    }
#pragma unroll
    for (int qq = 0; qq < 2; ++qq) {
        u32x4 bbv[2], cv[2][3];
#pragma unroll
        for (int q = 0; q < 2; ++q) { const int it = tid + (qq * 2 + q) * 512; const int r = it >> 5, ch = (it & 31) * 8; const int sp = s0 + r;
            const bf16_t* pr = proj + (size_t)(t0 + r) * NPROJ;
            bbv[q] = *(const u32x4*)(pr + PC_SCB + ch);
#pragma unroll
            for (int k = 0; k < 3; ++k) { const int sq = sp + k - 1; cv[q][k] = (u32x4){0, 0, 0, 0};
                if (sq >= 0 && sq < SEQ) cv[q][k] = *(const u32x4*)(pr + (ptrdiff_t)(k - 1) * NPROJ + PC_SCC + ch); } }
#pragma unroll
        for (int q = 0; q < 2; ++q) { const int it = tid + (qq * 2 + q) * 512; const int r = it >> 5, ch = (it & 31) * 8;
            float acc8[8];
#pragma unroll
            for (int i = 0; i < 8; ++i) acc8[i] = 0.f;
#pragma unroll
            for (int k = 0; k < 3; ++k) { float cc[8]; unpack8(cv[q][k], cc);
                const f32x4 w0 = *(const f32x4*)(sconv_w + k * 256 + ch), w1 = *(const f32x4*)(sconv_w + k * 256 + ch + 4);
#pragma unroll
                for (int i = 0; i < 4; ++i) { acc8[i] += w0[i] * cc[i]; acc8[4 + i] += w1[i] * cc[4 + i]; } }
            float bf[8]; unpack8(bbv[q], bf);
#pragma unroll
            for (int i = 0; i < 8; ++i) acc8[i] *= bf[i];
            *(u32x4*)(mixin + (size_t)(t0 + r) * DM + 256 + ch) = pack8(acc8); }
    }
    __syncthreads();
    {
        const int c = tid & 255, half = tid >> 8;
        float w[31];
#pragma unroll
        for (int k = 0; k < 31; ++k) w[k] = cconv_w[k * 256 + c];
        const float bias = cconv_b[c];
        float uu[62];
#pragma unroll
        for (int i = 0; i < 62; ++i) uu[i] = bf2f(ul[(half * 32 + i) * 256 + c]);
#pragma unroll
        for (int tt = 0; tt < 32; ++tt) {
            float a0 = bias, a1 = 0.f;
#pragma unroll
            for (int k = 0; k < 30; k += 2) { a0 += w[k] * uu[tt + k]; a1 += w[k + 1] * uu[tt + k + 1]; }
            a0 += w[30] * uu[tt + 30];
            vl[(half * 32 + tt) * 256 + c] = a0 + a1;
        }
    }
    __syncthreads();
    {
        const f32x4 gg = *(const f32x4*)(cnorm_g + lane * 4), bb = *(const f32x4*)(cnorm_b + lane * 4);
        for (int tt = 0; tt < 8; ++tt) {
            const int t = wave * 8 + tt;
            f32x4 v = *(const LAS f32x4*)(vl + t * 256 + lane * 4);
            const float mean = wave_sum(v[0] + v[1] + v[2] + v[3]) * (1.0f / 256.0f);
            v = v - mean;
            const float var = wave_sum(v[0] * v[0] + v[1] * v[1] + v[2] * v[2] + v[3] * v[3]) * (1.0f / 256.0f);
            const float rstd = 1.0f / sqrtf(var + LN_EPS);
            f32x4 y = v * rstd * gg + bb;
#pragma unroll
            for (int j = 0; j < 4; ++j) y[j] = y[j] * fast_sigmoid(y[j]);
            *(u32x2*)(mixin + (size_t)(t0 + t) * DM + 512 + lane * 4) = (u32x2){pk2(y[0], y[1]), pk2(y[2], y[3])};
        }
    }
    __syncthreads();
}

enum { SRC_IN = 0, SRC_UQ, SRC_UKV, SRC_PLAIN };
__device__ __forceinline__ int src_col_in(int n) {
    const int tile = n >> 8, p = n & 255;
    switch (tile) {
        case 0: return SC_QLAT + p;
        case 1: return p < 128 ? SC_KVLAT + p : (p < 160 ? SC_KROPE + (p - 128) : -1);
        case 2: return SC_SCB + p;
        case 3: return p < 128 ? SC_SCC + p : SC_SCH + (p - 128); case 4: return p < 128 ? SC_SCC + 128 + p : SC_SCH + 128 + (p - 128);
        case 5: return p < 128 ? SC_CFA + p : SC_CFG + (p - 128); case 6: return p < 128 ? SC_CFA + 128 + p : SC_CFG + 128 + (p - 128);
        case 7: { const int hh = p >> 6, pp = p & 63, w = pp >> 5, nn = (pp >> 4) & 1, j = pp & 15; return SC_GQQ + hh * 64 + 16 * w + j + 32 * nn; }
        default: { if (p < 128) { const int hh = p >> 6, pp = p & 63, w = pp >> 5, nn = (pp >> 4) & 1, j = pp & 15; return SC_GQK + hh * 64 + 16 * w + j + 32 * nn; } return SC_GQV + (p - 128); }
    }
}
__device__ __forceinline__ void transpose_item(const float* W0, const float* W1, int kind, int K, int Nsrc, int Nvalid, bf16_t* WT, const float* kscale, float mult,
                                               LAS float* scr, int item, int nblk, int lane) {
    const int kb = item / nblk, nb = item % nblk, k0 = 64 * kb, n0 = 32 * nb;
    const int n = n0 + (lane & 31);
    const float* src = nullptr;
    if (kind == SRC_IN) { const int tl = n >> 8; const bool pm_ = (tl == 0) || (tl >= 2 && tl <= 6) || (tl == 1 && (n & 255) < 128);
        const int sc = src_col_in(pm_ ? ((n & ~31) + perm32(n & 31)) : n); if (sc >= 0) src = W0 + sc; }
    else if (kind == SRC_UQ || kind == SRC_UKV) { if (n < Nvalid) src = W0 + n; }
    else if (kind == SRC_PLAIN) { src = W0 + (n & ~31) + perm32(n & 31); }
    else { const int j = n >> 8, r = n & 255; src = (r < 128) ? W0 + 128 * j + r : W1 + 128 * j + (r - 128); }
#pragma unroll 8
    for (int i = 0; i < 32; ++i) { const int kk = 2 * i + (lane >> 5); float v = 0.f; if (src) v = src[(size_t)(k0 + kk) * Nsrc]; if (kscale) v *= kscale[k0 + kk] * mult; scr[kk * 33 + (lane & 31)] = v; }
    asm volatile("s_waitcnt lgkmcnt(0)" ::: "memory");
    const int c = lane & 7;
#pragma unroll
    for (int j = 0; j < 4; ++j) { const int nn = (lane >> 3) + 8 * j; const LAS float* s = scr + (8 * c) * 33 + nn;
        u32x4 o; o.x = pk2(s[0 * 33], s[1 * 33]); o.y = pk2(s[2 * 33], s[3 * 33]); o.z = pk2(s[4 * 33], s[5 * 33]); o.w = pk2(s[6 * 33], s[7 * 33]);
        *(u32x4*)(WT + (size_t)(n0 + nn) * K + k0 + 8 * c) = o; }
    asm volatile("s_waitcnt lgkmcnt(0)" ::: "memory");
}
constexpr int SRC_GU = 9;

__device__ __forceinline__ void transpose64(const float* Wsrc, int Nsrc, bf16_t* WTdst, int K, LAS float* scr, int lane) {
    f32x4 v[16];
#pragma unroll
    for (int i = 0; i < 16; ++i) v[i] = __builtin_nontemporal_load((const f32x4*)(Wsrc + (size_t)(4 * i + (lane >> 4)) * Nsrc + (lane & 15) * 4));
#pragma unroll
    for (int i = 0; i < 16; ++i) { LAS float* d = scr + (4 * i + (lane >> 4)) * 65 + (lane & 15) * 4; d[0] = v[i][0]; d[1] = v[i][1]; d[2] = v[i][2]; d[3] = v[i][3]; }
    asm volatile("s_waitcnt lgkmcnt(0)" ::: "memory");
    const int c = lane & 7;
#pragma unroll
    for (int j = 0; j < 8; ++j) { const int nn = (lane >> 3) + 8 * j; const LAS float* s = scr + (8 * c) * 65 + (nn & 32) + perm32(nn & 31);
        u32x4 o; o.x = pk2(s[0 * 65], s[1 * 65]); o.y = pk2(s[2 * 65], s[3 * 65]); o.z = pk2(s[4 * 65], s[5 * 65]); o.w = pk2(s[6 * 65], s[7 * 65]);
        *(u32x4*)(WTdst + (size_t)nn * K + 8 * c) = o; }
    asm volatile("s_waitcnt lgkmcnt(0)" ::: "memory");
}


__device__ __forceinline__ void transpose64_fp8(const float* Wsrc, int Nsrc, unsigned char* WTdst, int Kb, float sc, LAS float* scr, int lane) {
    f32x4 v[16];
#pragma unroll
    for (int i = 0; i < 16; ++i) v[i] = __builtin_nontemporal_load((const f32x4*)(Wsrc + (size_t)(4 * i + (lane >> 4)) * Nsrc + (lane & 15) * 4));
#pragma unroll
    for (int i = 0; i < 16; ++i) { LAS float* d = scr + (4 * i + (lane >> 4)) * 65 + (lane & 15) * 4; d[0] = v[i][0]; d[1] = v[i][1]; d[2] = v[i][2]; d[3] = v[i][3]; }
    asm volatile("s_waitcnt lgkmcnt(0)" ::: "memory");
    const int c = lane & 7;
#pragma unroll
    for (int j = 0; j < 8; ++j) { const int nn = (lane >> 3) + 8 * j; const LAS float* s = scr + (8 * c) * 65 + (nn & 32) + perm32(nn & 31);
        int w0 = __builtin_amdgcn_cvt_pk_fp8_f32(s[0 * 65] * sc, s[1 * 65] * sc, 0, false); w0 = __builtin_amdgcn_cvt_pk_fp8_f32(s[2 * 65] * sc, s[3 * 65] * sc, w0, true);
        int w1 = __builtin_amdgcn_cvt_pk_fp8_f32(s[4 * 65] * sc, s[5 * 65] * sc, 0, false); w1 = __builtin_amdgcn_cvt_pk_fp8_f32(s[6 * 65] * sc, s[7 * 65] * sc, w1, true);
        *(u32x2*)(WTdst + (size_t)nn * Kb + 8 * c) = (u32x2){(unsigned)w0, (unsigned)w1}; }
    asm volatile("s_waitcnt lgkmcnt(0)" ::: "memory");
}

#define XB_TMO      128
#define XB_XCNT(j)  (256  + 64 * (j))
#define XB_XSUB(j)  (1280 + 64 * (j))
#define XB_XGEN(j)  (2304 + 64 * (j))
#define XB_TOP      3328
#define XB_TOPGEN   3392
#define XB_SPIN_CAP (1u << 22)
__device__ __forceinline__ unsigned xb_ld(unsigned* p)              { return __hip_atomic_load(p, __ATOMIC_RELAXED, __HIP_MEMORY_SCOPE_AGENT); }
__device__ __forceinline__ unsigned xb_add(unsigned* p, unsigned v) { return __hip_atomic_fetch_add(p, v, __ATOMIC_RELAXED, __HIP_MEMORY_SCOPE_AGENT); }
__device__ __forceinline__ unsigned xb_xcc_id() { return (unsigned)__builtin_amdgcn_s_getreg((3 << 11) | 20) & 0xFu; }
#define XB_SPIN(cond, bar) do { unsigned _sp = 0; while (cond) { __builtin_amdgcn_s_sleep(1); \
    if ((++_sp & 255u) == 0u) { if (xb_ld(&(bar)[XB_TMO])) break; if (_sp > XB_SPIN_CAP) { atomicAdd(&(bar)[XB_TMO], 1u); break; } } } } while (0)
__device__ __forceinline__ void xcd_barrier_complete(unsigned* bar, unsigned x, unsigned& nloc, unsigned& nx) {
    const unsigned G = gridDim.x * gridDim.y * gridDim.z;
    unsigned sum, cnt, mine, sp = 0u;
    for (;;) {
        sum = 0u; cnt = 0u; mine = 0u;
#pragma unroll
        for (unsigned j = 0; j < 16; ++j) { const unsigned c = xb_ld(&bar[XB_XCNT(j)]); sum += c; cnt += (c > 0u) ? 1u : 0u; mine = (j == x) ? c : mine; }
        if (sum == G) break;
        __builtin_amdgcn_s_sleep(1);
        if ((++sp & 255u) == 0u) { if (xb_ld(&bar[XB_TMO])) break; if (sp > XB_SPIN_CAP) { atomicAdd(&bar[XB_TMO], 1u); break; } }
    }
    nloc = mine > 0u ? mine : 1u; nx = cnt > 0u ? cnt : 1u;
}
__device__ __forceinline__ void xcd_barrier(unsigned* bar, volatile LAS unsigned* st) {
    asm volatile("" : "+s"(bar));
    asm volatile("s_waitcnt vmcnt(0)" ::: "memory");
    __syncthreads();
    if (threadIdx.x == 0) {
        __builtin_amdgcn_s_waitcnt(0);
        const unsigned x = xb_xcc_id();
        unsigned nloc = st[0], nx = st[1];
        if (nloc == 0u) { xcd_barrier_complete(bar, x, nloc, nx); st[0] = nloc; st[1] = nx; }
        __builtin_amdgcn_fence(__ATOMIC_RELEASE, "agent"); asm volatile("s_waitcnt vmcnt(0)" ::: "memory");
        const unsigned old = xb_add(&bar[XB_XSUB(x)], 1u);
        const unsigned gen = old / nloc;
        if (old + 1u == (gen + 1u) * nloc) {
            __builtin_amdgcn_fence(__ATOMIC_RELEASE, "agent");
            asm volatile("s_waitcnt vmcnt(0)" ::: "memory");
            (void)xb_add(&bar[XB_TOP], 1u);
            XB_SPIN(xb_ld(&bar[XB_TOP]) < (gen + 1u) * nx, bar);
            __builtin_amdgcn_fence(__ATOMIC_ACQUIRE, "agent");
            xb_add(&bar[XB_XGEN(x)], 1u);
            asm volatile("s_waitcnt vmcnt(0)" ::: "memory");
        } else {
            XB_SPIN(xb_ld(&bar[XB_XGEN(x)]) == gen, bar);
            __builtin_amdgcn_fence(__ATOMIC_ACQUIRE, "agent");
            asm volatile("s_waitcnt vmcnt(0)" ::: "memory");
        }
    }
    __syncthreads();
}

struct Args { const void* in[23]; float* out; unsigned char* ws; int ph_lo, ph_hi; };
constexpr int NPH = 10;

__global__ void __launch_bounds__(512, 2) fwd_kernel(Args args) {
    extern __shared__ __attribute__((aligned(16))) unsigned char lds_raw[];
    typedef const __attribute__((address_space(4))) unsigned char* kaptr_t;
#define PH_PROLOG \
    kaptr_t ka = (kaptr_t)__builtin_amdgcn_kernarg_segment_ptr(); asm volatile("" : "+s"(ka)); \
    unsigned char* ws = ((unsigned char* const __attribute__((address_space(4)))*)ka)[24]; float* xres = ((float* const __attribute__((address_space(4)))*)ka)[23]; (void)xres; (void)ws; \
    int G = gridDim.x, bx = blockIdx.x; asm volatile("" : "+s"(G), "+s"(bx)); const int vcu = (G % 8 == 0) ? (bx % 8) * (G / 8) + bx / 8 : bx; const int NGW = G * 8; (void)NGW; \
    int tid = threadIdx.x; asm volatile("" : "+v"(tid)); const int lane = tid & 63, wave = __builtin_amdgcn_readfirstlane(tid >> 6); const int gw = vcu * 8 + wave; (void)lane; (void)gw;
#define INF(i) ((const float*)(((const void* const __attribute__((address_space(4)))*)ka)[i]))
#define WSP(T, off) ((T*)(ws + (off)))
    volatile LAS unsigned* xb_st = (volatile LAS unsigned*)((LAS unsigned char*)lds_raw + GIDX_OFF + GIDX_BYTES);
    if (threadIdx.x < 2) xb_st[threadIdx.x] = 0u;
    if (threadIdx.x == 0) (void)xb_add((unsigned*)args.ws + 4096 + XB_XCNT(xb_xcc_id()), 1u);
    __syncthreads();
#define GRID_SYNC() xcd_barrier((unsigned*)args.ws + 4096, xb_st)
    const int lo = args.ph_lo, hi = args.ph_hi;
    LAS unsigned char* lds = (LAS unsigned char*)lds_raw;
#ifndef PHMASK
#define PHMASK 0x3ff
#endif
#define IN_PH(k) (((PHMASK >> ((k) % NPH)) & 1) && lo <= (k) && (k) < hi)
#ifndef PROBE_PH
#define PROBE_PH -1
#endif
#ifndef PROBE_N
#define PROBE_N 1
#endif
#define REPS(k) for (int rep_ = 0; rep_ < ((PROBE_PH == (k)) ? 1 + PROBE_N : 1); ++rep_)
#ifndef PROBE_SUB
#define PROBE_SUB -1
#endif
#define SUBREPS(i) for (int r2_ = 0; r2_ < ((PROBE_SUB == (i)) ? 2 : 1); ++r2_)
#define SEAM(k) do { if (IN_PH(k) && IN_PH((k) + 1)) GRID_SYNC(); } while (0)

#define CONVERT_SMALL(lw, scr_off) do { LAS float* scr = (LAS float*)(lds + (scr_off) + wave * 8448); \
            constexpr int I_IN = 16 * 72, I_UQ = 4 * 16, I_UKV = 2 * 16, I_OUT = 16 * 32; \
            for (int it = gw; it < I_IN + I_UQ + I_UKV + I_OUT; it += NGW) { \
                int r = it; \
                if (r < I_IN) { transpose_item(INF(2) + (size_t)(lw) * DM * DIN, nullptr, SRC_IN, DM, DIN, 0, WSP(bf16_t, WS_WIN), nullptr, 1.f, scr, r, 72, lane); continue; } r -= I_IN; \
                if (r < I_UQ) { transpose_item(INF(4) + (size_t)(lw) * 256 * 384, nullptr, SRC_UQ, 256, 384, 384, WSP(bf16_t, WS_WUQ), INF(3) + (lw) * 256, 0.10206207261596575f * LOG2E, scr, r, 16, lane); continue; } r -= I_UQ; \
                if (r < I_UKV) { transpose_item(INF(6) + (size_t)(lw) * 128 * 512, nullptr, SRC_UKV, 128, 512, 512, WSP(bf16_t, WS_WUKV), INF(5) + (lw) * 128, 1.f, scr, r, 16, lane); continue; } r -= I_UKV; \
                transpose_item(INF(13) + (size_t)(lw) * DM * DM, nullptr, SRC_PLAIN, DM, DM, DM, WSP(bf16_t, WS_WOUT), nullptr, 1.f, scr, r, 32, lane); \
            } } while (0)
    {
        if (IN_PH(0)) REPS(0) {
            PH_PROLOG
            CONVERT_SMALL(0, 0);
            {
                const int* positions = (const int*)INF(1);
                float* cosA = WSP(float, WS_COSA); float* sinA = WSP(float, WS_SINA); float* cosD = WSP(float, WS_COSD); float* sinD = WSP(float, WS_SIND);
                LAS float* inv_l = (LAS float*)(lds + 8 * 8448);
                if (tid < 48) inv_l[tid] = (tid < 16) ? 1.0f / powf(10000.0f, (float)(2 * tid) / 32.0f) : 1.0f / powf(10000.0f, (float)(2 * (tid - 16)) / 64.0f);
                __syncthreads();
                for (int i = bx * 512 + tid; i < NTOK * 48; i += G * 512) {
                    const int t = i / 48, j = i % 48; const float a = (float)positions[t] * inv_l[j];
                    float sn, cs; sincosf(a, &sn, &cs);
                    if (j < 16) { cosA[t * 16 + j] = cs; sinA[t * 16 + j] = sn; } else { cosD[t * 32 + j - 16] = cs; sinD[t * 32 + j - 16] = sn; }
                }
                const float* x_in = INF(0); bf16_t* xbf = WSP(bf16_t, WS_XBF);
                for (int m = gw; m < NTOK; m += 4 * NGW) {
                    f32x4 v[4][4];
#pragma unroll
                    for (int r = 0; r < 4; ++r)
#pragma unroll
                        for (int j = 0; j < 4; ++j) v[r][j] = __builtin_nontemporal_load((const f32x4*)(x_in + (size_t)(m + r * NGW) * DM) + lane + 64 * j);
#pragma unroll
                    for (int r = 0; r < 4; ++r)
#pragma unroll
                        for (int j = 0; j < 4; ++j) ((u32x2*)(xbf + (size_t)(m + r * NGW) * DM) + lane)[64 * j] = (u32x2){pk2(v[r][j][0], v[r][j][1]), pk2(v[r][j][2], v[r][j][3])};
                }
            }
        }
        SEAM(0);
    }
    for (int l = 0; l < DEPTH; ++l) {
        const int P = l * NPH;
        if (IN_PH(P + 1)) REPS(1) {
            PH_PROLOG
            pg8::Gemm g{WSP(bf16_t, WS_XBF), WSP(bf16_t, WS_WIN), DM, DM, DM, 0, 0}; pg8::Order S; S.init(NTOK, NPROJ, 1, G, bx);
            EpiProj E{WSP(bf16_t, WS_R1), WSP(float, WS_SSQQ), WSP(float, WS_SSQKV), WSP(unsigned char, WS_KM), WSP(bf16_t, WS_VTG), WSP(float, WS_COSA), WSP(float, WS_SINA), WSP(float, WS_COSD), WSP(float, WS_SIND)};
            pg8::gemm_phase<EpiProj, false, pg8::Order>(tid, lds, nullptr, g, S, E);
            {
                const int nwg = (NTOK / 256) * (NPROJ / 256), nfull = nwg % G;
                if (nfull != 0 && bx >= nfull) {
                    LAS float* scr = (LAS float*)(lds + wave * 16640);
                    const float* w_down = INF(20);
                    const int nidle = G - nfull;
                    for (int it = (bx - nfull) * 8 + wave; it < NE * 256; it += nidle * 8) {
                        const int e = it >> 8, r = it & 255, kb = r >> 4, nb = r & 15;
                        const size_t wo = ((size_t)l * NE + e) * DM * FF;
                        transpose64_fp8(w_down + wo + (size_t)kb * 64 * DM + nb * 64, DM, WSP(unsigned char, WS_WD) + ((size_t)e * DM + nb * 64) * FF + kb * 64, FF, 64.0f, scr, lane);
                    }
                }
            }
        }
        SEAM(P + 1);
        if (IN_PH(P + 2)) REPS(2) {
            { PH_PROLOG
              pg8::Gemm g{WSP(bf16_t, WS_R1) + PC_QLAT, WSP(bf16_t, WS_WUQ), NPROJ, 256, 256, 0, 0}; pg8::Order S; S.init(NTOK, 512, 1, G, bx);
              EpiQup E{WSP(unsigned char, WS_QM), WSP(float, WS_SSQQ), WSP(float, WS_COSA), WSP(float, WS_SINA)}; pg8::gemm_phase<EpiQup, false, pg8::Order>(tid, lds, nullptr, g, S, E); }
            { PH_PROLOG
              pg8::Gemm g{WSP(bf16_t, WS_R1) + PC_KVLAT, WSP(bf16_t, WS_WUKV), NPROJ, 128, 128, 0, 0}; pg8::Order S; S.init(NTOK, 512, 1, G, bx);
              EpiKVup E{WSP(unsigned char, WS_KM), WSP(unsigned char, WS_VTM), WSP(float, WS_SSQKV)}; pg8::gemm_phase<EpiKVup, false, pg8::Order>(tid, lds, nullptr, g, S, E); }
        }
        SEAM(P + 2);
        if (IN_PH(P + 3)) REPS(3) {
            SUBREPS(0) { PH_PROLOG
              const int per = (512 + G - 1) / G;
              bf16_t* mixin = WSP(bf16_t, WS_MIXIN);
              for (int u = vcu * per; u < (vcu + 1) * per && u < 512; ++u) {
                const int bh = u >> 4, qb = u & 15, b = bh >> 2, h = bh & 3;
                const unsigned char* Qw = WSP(unsigned char, WS_QM) + ((size_t)bh * SEQ + qb * 256 + wave * 32) * 96;
                bf16_t* Ow = mixin + ((size_t)b * SEQ + qb * 256 + wave * 32) * DM + h * 64;
                attn_mla_f8(tid, lds, Qw, WSP(unsigned char, WS_KM) + (size_t)bh * SEQ * 96, WSP(unsigned char, WS_VTM) + (size_t)bh * 64 * SEQ, Ow, DM);
              } }
            SUBREPS(1) { PH_PROLOG
              const int per = (512 + G - 1) / G;
              bf16_t* mixin = WSP(bf16_t, WS_MIXIN); const bf16_t* proj = WSP(bf16_t, WS_R1); const float* sink = INF(12);
              for (int u = vcu * per; u < (vcu + 1) * per && u < 512; ++u) {
                const int bk = u >> 5, nb = u & 31, b = bk >> 1, kvh = bk & 1;
                const int gi = wave >> 2, qoff = nb * 128 + (wave & 3) * 32, hq = kvh * 2 + gi;
                const bf16_t* Qw = proj + ((size_t)b * SEQ + qoff) * NPROJ + PC_GQQ + hq * 64;
                const bf16_t* Kb = proj + (size_t)b * SEQ * NPROJ + PC_GQK + kvh * 64;
                bf16_t* Ow = mixin + ((size_t)b * SEQ + qoff) * DM + 768 + hq * 64;
                const int t_lo = (2 * nb - 2) < 0 ? 0 : (2 * nb - 2), t_hi = (2 * nb + 4) > 64 ? 64 : (2 * nb + 4);
                attn_unit<64, true>(tid, lds, Qw, NPROJ, Kb, NPROJ, WSP(bf16_t, WS_VTG) + (size_t)bk * 64 * SEQ, Ow, DM, qoff, t_lo, t_hi, sink[l * 4 + hq] * LOG2E);
              } }
            SUBREPS(2) { PH_PROLOG
              const int per = (512 + G - 1) / G;
              for (int u = vcu * per; u < (vcu + 1) * per && u < 512; ++u)
                conv_unit(tid, lds, WSP(bf16_t, WS_R1), WSP(bf16_t, WS_MIXIN), u, INF(7) + l * 3 * 256, INF(8) + l * 31 * 256, INF(9) + l * 256, INF(10) + l * 256, INF(11) + l * 256);
            }
        }
        SEAM(P + 3);
        if (IN_PH(P + 4)) REPS(4) {
            PH_PROLOG
            pg8::Gemm g{WSP(bf16_t, WS_MIXIN), WSP(bf16_t, WS_WOUT), DM, DM, DM, 0, 0}; pg8::Order S; S.init(NTOK, DM, 1, G, bx);
            EpiOut E{WSP(bf16_t, WS_XBF)};
            pg8::gemm_phase<EpiOut, false, pg8::Order>(tid, lds, nullptr, g, S, E);
        }
        SEAM(P + 4);
        if (IN_PH(P + 5)) REPS(5) {
            { PH_PROLOG
            LAS bf16_t* wr_l = (LAS bf16_t*)lds;
            LAS float* g_l = (LAS float*)(lds + 32768);
            LAS float* b_l = (LAS float*)(lds + 32768 + 4096);
            const float* w_router = INF(16); const float* b_router = INF(17);
            for (int i = tid; i < DM * NE; i += 512) { const int d = i >> 4, e = i & 15; wr_l[(((d >> 5) * 4 + ((d >> 3) & 3)) * 16 + e) * 8 + (d & 7)] = f2bf(w_router[(size_t)l * DM * NE + i]); }
            for (int i = tid; i < DM; i += 512) { g_l[i] = INF(14)[l * DM + i]; b_l[i] = INF(15)[l * DM + i]; }
            __syncthreads();
            const int tk = lane & 15, g4 = lane >> 4;
            const float brt = b_router[l * NE + tk];
            bf16_t* xbf = WSP(bf16_t, WS_XBF); float* aff_t = WSP(float, WS_AFF); unsigned char* xf8 = WSP(unsigned char, WS_XF8);
            for (int m0 = gw * 16; m0 < NTOK; m0 += NGW * 16) {
                bf16_t* xrow = xbf + (size_t)(m0 + tk) * DM + g4 * 8;
                u32x4 xp[32];
#pragma unroll
                for (int s_ = 0; s_ < 32; ++s_) xp[s_] = *(const u32x4*)(xrow + 32 * s_);
                float s1 = 0.f, s2 = 0.f;
#pragma unroll
                for (int s_ = 0; s_ < 32; ++s_) { float v[8]; unpack8(xp[s_], v);
#pragma unroll
                    for (int j = 0; j < 8; ++j) { s1 += v[j]; s2 += v[j] * v[j]; } asm volatile("" : "+v"(s1), "+v"(s2)); }
                s1 += __shfl_xor(s1, 16); s1 += __shfl_xor(s1, 32); s2 += __shfl_xor(s2, 16); s2 += __shfl_xor(s2, 32);
                const float mean = s1 * (1.0f / DM); const float var = fmaxf(s2 * (1.0f / DM) - mean * mean, 0.f);
                const float rstd = 1.0f / sqrtf(var + LN_EPS);
                f32x4 lg = {0.f, 0.f, 0.f, 0.f};
#pragma unroll
                for (int s_ = 0; s_ < 32; ++s_) {
                    asm volatile("" : "+v"(xp[s_]));
                    float v[8]; unpack8(xp[s_], v);
                    const f32x4 ga = *(const LAS f32x4*)(g_l + 32 * s_ + 8 * g4), gb = *(const LAS f32x4*)(g_l + 32 * s_ + 8 * g4 + 4);
                    const f32x4 ba = *(const LAS f32x4*)(b_l + 32 * s_ + 8 * g4), bb_ = *(const LAS f32x4*)(b_l + 32 * s_ + 8 * g4 + 4);
#pragma unroll
                    for (int j = 0; j < 4; ++j) { v[j] = (v[j] - mean) * rstd * ga[j] + ba[j]; v[4 + j] = (v[4 + j] - mean) * rstd * gb[j] + bb_[j]; }
                    const u32x4 o = pack8(v);
                    *(u32x4*)(xrow + 32 * s_) = o;
                    { int w0 = __builtin_amdgcn_cvt_pk_fp8_f32(v[0], v[1], 0, false); w0 = __builtin_amdgcn_cvt_pk_fp8_f32(v[2], v[3], w0, true);
                      int w1 = __builtin_amdgcn_cvt_pk_fp8_f32(v[4], v[5], 0, false); w1 = __builtin_amdgcn_cvt_pk_fp8_f32(v[6], v[7], w1, true);
                      *(u32x2*)(xf8 + (size_t)(m0 + tk) * DM + 32 * s_ + 8 * g4) = (u32x2){(unsigned)w0, (unsigned)w1}; }
                    const bf16x8 wf = *(const LAS bf16x8*)(wr_l + ((s_ * 4 + g4) * 16 + tk) * 8);
                    lg = __builtin_amdgcn_mfma_f32_16x16x32_bf16(__builtin_bit_cast(bf16x8, o), wf, lg, 0, 0, 0);
                    asm volatile("" ::: "memory");
                }
                f32x4 av;
#pragma unroll
                for (int r = 0; r < 4; ++r) {
                    const float lgt = lg[r] + brt; float mx = lgt;
#pragma unroll
                    for (int o = 1; o < 16; o <<= 1) mx = fmaxf(mx, __shfl_xor(mx, o));
                    const float ev = __expf(lgt - mx); float den = ev;
#pragma unroll
                    for (int o = 1; o < 16; o <<= 1) den += __shfl_xor(den, o);
                    av[r] = ev / den;
                }
                { const int mt = m0 + 4 * g4, b = mt / SEQ, sq = mt % SEQ; *(f32x4*)(aff_t + ((size_t)b * NE + tk) * SEQ + sq) = av; }
            }
            __syncthreads();
            }
#ifdef PROBE_CONV
            for (int rc_ = 0; rc_ < 2; ++rc_)
#endif
            { PH_PROLOG
            LAS float* scr = (LAS float*)(lds + wave * 16640);
            constexpr int I_GU = 16 * 32, I_D = 16 * 16;
            const float* w_gate = INF(18); const float* w_up = INF(19); const float* w_down = INF(20);
            for (int it = gw; it < NE * (I_GU + I_D); it += NGW) {
                const int e = it / (I_GU + I_D); int r = it % (I_GU + I_D);
                const size_t wo = ((size_t)l * NE + e) * DM * FF;
                if (r < I_GU) { const int kb = r >> 5, nb = r & 31, n0 = nb * 64, j = n0 >> 8, rr = n0 & 255;
                    const float* src = (rr < 128 ? w_gate + wo + 128 * j + rr : w_up + wo + 128 * j + (rr - 128)) + (size_t)kb * 64 * FF;
                    transpose64_fp8(src, FF, WSP(unsigned char, WS_WGU) + ((size_t)e * 2048 + n0) * DM + kb * 64, DM, rr < 128 ? 32.0f * LOG2E : 32.0f / LOG2E, scr, lane); }
                else if (((NTOK / 256) * (NPROJ / 256)) % G == 0) { r -= I_GU; const int kb = r >> 4, nb = r & 15;
                    transpose64_fp8(w_down + wo + (size_t)kb * 64 * DM + nb * 64, DM, WSP(unsigned char, WS_WD) + ((size_t)e * DM + nb * 64) * FF + kb * 64, FF, 64.0f, scr, lane); }
            }
            __syncthreads();
            if (l + 1 < DEPTH) CONVERT_SMALL(l + 1, 0);
            }
        }
        SEAM(P + 5);
        if (IN_PH(P + 7)) REPS(7) {
            PH_PROLOG
            pg8::PanelOrder S; S.init(bx, 8);
            LAS int* gidx = (LAS int*)(lds + GIDX_OFF);
            LAS float* gate_l = (LAS float*)(lds + GIDX_OFF + 1024);
            {
                LAS unsigned* hist = (LAS unsigned*)lds;
                LAS unsigned* wtot = (LAS unsigned*)(lds + 4096);
                const float* aff_t = WSP(float, WS_AFF); int* slot_of = WSP(int, WS_SLOT);
                const int e = S.e, b = S.pm >> 1, half = S.pm & 1, p = b * NE + e;
                unsigned key[8];
                { const u32x4 a0 = *((const u32x4*)(aff_t + (size_t)p * SEQ) + 2 * tid), a1 = *((const u32x4*)(aff_t + (size_t)p * SEQ) + 2 * tid + 1);
                  key[0] = a0[0]; key[1] = a0[1]; key[2] = a0[2]; key[3] = a0[3]; key[4] = a1[0]; key[5] = a1[1]; key[6] = a1[2]; key[7] = a1[3]; }
                for (int i = tid; i < 1024; i += 512) hist[i] = 0u;
                __syncthreads();
                unsigned prefix = 0u, pmask = 0u, kneed = CAP;
#pragma unroll
                for (int pass = 0; pass < 4; ++pass) {
                    const int shift = 24 - 8 * pass;
                    LAS unsigned* h = hist + pass * 256;
#pragma unroll
                    for (int j = 0; j < 8; ++j) if ((key[j] & pmask) == prefix) atomicAdd((unsigned*)(h + ((key[j] >> shift) & 255u)), 1u);
                    __syncthreads();
                    const u32x4 c = *((const LAS u32x4*)h + lane);
                    const unsigned own = c[0] + c[1] + c[2] + c[3];
                    unsigned suf = own;
#pragma unroll
                    for (int o = 1; o < 64; o <<= 1) { const unsigned t = __shfl_down(suf, o); if (lane + o < 64) suf += t; }
                    unsigned above = suf - own;
                    int found = -1; unsigned knew = 0u;
#pragma unroll
                    for (int q = 3; q >= 0; --q) { if (found < 0 && above < kneed && above + c[q] >= kneed) { found = 4 * lane + q; knew = kneed - above; } above += c[q]; }
                    const unsigned long long bm = __ballot(found >= 0);
                    const int src = __builtin_ctzll(bm);
                    const unsigned d = (unsigned)__builtin_amdgcn_readlane(found, src); kneed = (unsigned)__builtin_amdgcn_readlane((int)knew, src);
                    prefix |= d << shift; pmask |= 255u << shift;
                }
                unsigned ngt = 0u, neq = 0u;
#pragma unroll
                for (int j = 0; j < 8; ++j) { ngt += (key[j] > prefix) ? 1u : 0u; neq += (key[j] == prefix) ? 1u : 0u; }
                unsigned packed = ngt | (neq << 16), inc = packed;
#pragma unroll
                for (int o = 1; o < 64; o <<= 1) { const unsigned t = __shfl_up(inc, o); if (lane >= o) inc += t; }
                if (lane == 63) wtot[wave] = inc;
                __syncthreads();
                unsigned base = 0u;
                for (int w = 0; w < wave; ++w) base += wtot[w];
                unsigned excl = base + inc - packed;
                unsigned rgt = excl & 0xffffu, req = excl >> 16;
                const unsigned cnt_gt = CAP - kneed;
                int so[8];
#pragma unroll
                for (int j = 0; j < 8; ++j) {
                    int slot = -1;
                    if (key[j] > prefix) { slot = (int)rgt; ++rgt; }
                    else if (key[j] == prefix) { if (req < kneed) slot = (int)(cnt_gt + req); ++req; }
                    so[j] = slot;
                    if (slot >= 0 && (slot >> 8) == half) { gidx[slot & 255] = b * SEQ + 8 * tid + j; gate_l[slot & 255] = __uint_as_float(key[j]); }
                }
                if (half == 0) {
                    *((u32x4*)(slot_of + (size_t)p * SEQ) + 2 * tid) = (u32x4){(unsigned)so[0], (unsigned)so[1], (unsigned)so[2], (unsigned)so[3]};
                    *((u32x4*)(slot_of + (size_t)p * SEQ) + 2 * tid + 1) = (u32x4){(unsigned)so[4], (unsigned)so[5], (unsigned)so[6], (unsigned)so[7]};
                }
                __syncthreads();
            }
            pg8::Gemm g{WSP(bf16_t, WS_XF8), WSP(bf16_t, WS_WGU), DM / 2, DM / 2, DM / 2, 0, (long)2048 * (DM / 2), 0x7A7A7A7A, 0x7F7F7F7F};
            EpiGateUp E{WSP(unsigned char, WS_R1)};
            pg8::gemm_phase<EpiGateUp, true, pg8::PanelOrder, 0, true>(tid, lds, gidx, g, S, E);
        }
        if (IN_PH(P + 7)) { asm volatile("s_waitcnt vmcnt(0)" ::: "memory"); __syncthreads();
            __builtin_amdgcn_fence(__ATOMIC_ACQUIRE, "workgroup");
            __syncthreads(); }
        if (IN_PH(P + 8)) REPS(8) {
            PH_PROLOG
            pg8::PanelOrder S; S.init(bx, 4);
            LAS int* hidx = (LAS int*)(lds + GIDX_OFF + 2048);
            for (int r = tid; r < 256; r += 512) hidx[r] = S.e * EROWS + S.pm * 256 + r;
            __syncthreads();
            pg8::Gemm g{WSP(bf16_t, WS_R1), WSP(bf16_t, WS_WD), FF / 2, FF / 2, FF / 2, 0, (long)DM * (FF / 2), 0x79797979, 0x7F7F7F7F};
            EpiDown E{WSP(unsigned char, WS_R2), (const LAS float*)(lds + GIDX_OFF + 1024)};
            pg8::gemm_phase<EpiDown, true, pg8::PanelOrder, 0, true>(tid, lds, hidx, g, S, E);
        }
        SEAM(P + 8);
        if (IN_PH(P + 9)) REPS(9)
#ifdef PROBE_P9F
        for (int r9_ = 0; r9_ < ((l == DEPTH - 1) ? 2 : 1); ++r9_)
#endif
        {
            PH_PROLOG
            const int cg = 32 * (lane >> 4) + (lane & 15);
            float gg[16], bb[16];
            { const float* g2 = INF(21) + l * DM; const float* b2 = INF(22) + l * DM;
#pragma unroll
              for (int j = 0; j < 2; ++j)
#pragma unroll
                for (int i = 0; i < 8; ++i) { gg[8 * j + i] = g2[8 * (cg + 16 * j) + i]; bb[8 * j + i] = b2[8 * (cg + 16 * j) + i]; } }
            const int* slot_of = WSP(int, WS_SLOT); const unsigned char* slab = WSP(unsigned char, WS_R2); bf16_t* xbf = WSP(bf16_t, WS_XBF);
            const bool final_layer = (l == DEPTH - 1);
            for (int m0 = gw * 4; m0 < NTOK; m0 += NGW * 4) {
                const int b = m0 / SEQ, s0 = m0 % SEQ;
                const int sl = slot_of[((size_t)b * NE + (lane & 15)) * SEQ + s0 + (lane >> 4)];
                u32x4 raw[4][2];
#pragma unroll
                for (int t = 0; t < 4; ++t)
#pragma unroll
                    for (int j = 0; j < 2; ++j) raw[t][j] = *((const u32x4*)(xbf + (size_t)(m0 + t) * DM) + cg + 16 * j);
                const unsigned long long bal = __ballot(sl >= 0);
                u32x4 g0[4], g1[4]; unsigned rest[4]; bool h0[4], h1[4];
#pragma unroll
                for (int t = 0; t < 4; ++t) {
                    unsigned mt = (unsigned)(bal >> (16 * t)) & 0xffffu;
                    h0[t] = mt != 0u; const int e0 = h0[t] ? __builtin_ctz(mt) : 0; mt &= mt - 1u;
                    h1[t] = mt != 0u; const int e1 = h1[t] ? __builtin_ctz(mt) : e0; if (h1[t]) mt &= mt - 1u;
                    rest[t] = mt;
                    int s0_ = __builtin_amdgcn_readlane(sl, 16 * t + e0), s1_ = __builtin_amdgcn_readlane(sl, 16 * t + e1);
                    s0_ = s0_ < 0 ? 0 : s0_; s1_ = s1_ < 0 ? 0 : s1_;
                    g0[t] = __builtin_nontemporal_load((const u32x4*)(slab + ((size_t)e0 * EROWS + b * CAP + s0_) * DM) + lane);
                    g1[t] = __builtin_nontemporal_load((const u32x4*)(slab + ((size_t)e1 * EROWS + b * CAP + s1_) * DM) + lane);
                }
#pragma unroll
                for (int t = 0; t < 4; ++t) {
                    const int m = m0 + t;
                    float v[16]; unpack8(raw[t][0], v); unpack8(raw[t][1], v + 8);
#pragma unroll
                    for (int i = 0; i < 16; ++i) v[i] *= ALPHA;
                    if (h0[t]) acc16_fp8(g0[t], v, 1.0f / 64.0f);
                    if (h1[t]) acc16_fp8(g1[t], v, 1.0f / 64.0f);
                    unsigned mt = rest[t];
                    while (mt) {
                        const int e = __builtin_ctz(mt); mt &= mt - 1u;
                        const int se = __builtin_amdgcn_readlane(sl, 16 * t + e);
                        acc16_fp8(*((const u32x4*)(slab + ((size_t)e * EROWS + b * CAP + se) * DM) + lane), v, 1.0f / 64.0f);
                    }
                    ln_row16(v, gg, bb);
                    if (final_layer) {
#pragma unroll
                        for (int j = 0; j < 2; ++j) { f32x4* o = (f32x4*)(xres + (size_t)m * DM) + 2 * (cg + 16 * j);
                            __builtin_nontemporal_store((f32x4){v[8 * j], v[8 * j + 1], v[8 * j + 2], v[8 * j + 3]}, o); __builtin_nontemporal_store((f32x4){v[8 * j + 4], v[8 * j + 5], v[8 * j + 6], v[8 * j + 7]}, o + 1); } }
                    else { *((u32x4*)(xbf + (size_t)m * DM) + cg) = pack8(v); *((u32x4*)(xbf + (size_t)m * DM) + cg + 16) = pack8(v + 8); }
                }
            }
        }
        if (l + 1 < DEPTH) SEAM(P + 9);
    }
}

extern "C" void kernel_launch(void* const* d_in, const int* in_sizes, int n_in, void* d_out, int out_size, void* d_ws, size_t ws_size, hipStream_t stream) {
    static int grid = 0;
    if (grid == 0) {
        if (n_in != 23 || out_size != NTOK * DM || ws_size < WS_END) { fprintf(stderr, "kernel_launch: unexpected problem (n_in %d out %d ws %zu need %zu)\n", n_in, out_size, ws_size, (size_t)WS_END); grid = -1; return; }
        int dev = 0, cus = 0, per_cu = 0;
        (void)hipGetDevice(&dev);
        (void)hipDeviceGetAttribute(&cus, hipDeviceAttributeMultiprocessorCount, dev);
        (void)hipFuncSetAttribute((const void*)fwd_kernel, hipFuncAttributeMaxDynamicSharedMemorySize, LDS_BYTES);
        (void)hipOccupancyMaxActiveBlocksPerMultiprocessor(&per_cu, (const void*)fwd_kernel, 512, LDS_BYTES);
        (void)hipGetLastError();
        grid = 256;
        if (cus != 256 || per_cu < 1) fprintf(stderr, "kernel_launch: built for a 256-CU device with one resident workgroup per CU (cus %d, per_cu %d)\n", cus, per_cu);
        fprintf(stderr, "kernel_launch: cus %d per_cu %d grid %d ws %zu\n", cus, per_cu, grid, ws_size);
    }
    if (grid < 0) return;
    (void)hipMemsetAsync((char*)d_ws + WS_CTL, 0, 32768, stream);
    Args a{};
    for (int i = 0; i < 23; ++i) a.in[i] = d_in[i];
    a.out = (float*)d_out; a.ws = (unsigned char*)d_ws;
    a.ph_lo = 0; a.ph_hi = DEPTH * NPH;
    void* kargs[] = {&a};
    hipError_t e = hipLaunchCooperativeKernel((const void*)fwd_kernel, dim3(grid), dim3(512), kargs, LDS_BYTES, stream);
    if (e != hipSuccess) fprintf(stderr, "cooperative launch failed: %s (grid %d)\n", hipGetErrorString(e), grid);
}
```

```cpp
#include <hip/hip_runtime.h>
#include <hip/hip_cooperative_groups.h>
#include <cstdio>
#include <cstdint>
namespace cg = cooperative_groups;


#define LAS __attribute__((address_space(3)))
typedef unsigned short bf16_t;
typedef short bf16x8 __attribute__((ext_vector_type(8)));
typedef short s16x4 __attribute__((ext_vector_type(4)));
typedef float f32x2 __attribute__((ext_vector_type(2)));
typedef float f32x4 __attribute__((ext_vector_type(4)));
typedef float f32x16 __attribute__((ext_vector_type(16)));
typedef unsigned u32x2 __attribute__((ext_vector_type(2)));
typedef unsigned u32x4 __attribute__((ext_vector_type(4)));
typedef __bf16 bf16x2_t __attribute__((ext_vector_type(2)));
typedef int v4i_t __attribute__((ext_vector_type(4)));
typedef int v8i_t __attribute__((ext_vector_type(8)));

constexpr int NB = 8, SEQ = 4096, DM = 1024, NTOK = NB * SEQ, DEPTH = 2;
constexpr int DIN = 2208, NPROJ = 2304;
constexpr int NE = 16, FF = 1024, CAP = 512, EROWS = NB * CAP;
constexpr float LN_EPS = 1e-5f, RMS_EPS = 1e-6f, ALPHA = 1.41421356237309515f;
constexpr float LOG2E = 1.4426950408889634f;
constexpr int PC_QLAT = 0, PC_KVLAT = 256, PC_KROPE = 384, PC_SCB = 512, PC_SCC = 768, PC_SCH = 1024, PC_CFA = 1280, PC_CFG = 1536, PC_GQQ = 1792, PC_GQK = 2048, PC_GQV = 2176;
constexpr int SC_QLAT = 0, SC_KVLAT = 256, SC_KROPE = 384, SC_SCB = 416, SC_SCC = 672, SC_SCH = 928, SC_CFA = 1184, SC_CFG = 1440, SC_GQQ = 1696, SC_GQK = 1952, SC_GQV = 2080;

constexpr size_t MiB = 1u << 20;
constexpr size_t WS_CTL = 0;
constexpr size_t WS_COSA = 1 * MiB, WS_SINA = 3 * MiB;
constexpr size_t WS_COSD = 5 * MiB, WS_SIND = 9 * MiB;
constexpr size_t WS_SSQQ = 13 * MiB, WS_SSQKV = 13 * MiB + 512 * 1024;
constexpr size_t WS_AFF = 14 * MiB;
constexpr size_t WS_SLOT = 17 * MiB;
constexpr size_t WS_WIN = 20 * MiB;
constexpr size_t WS_WUQ = 25 * MiB;
constexpr size_t WS_WUKV = 25 * MiB + 512 * 1024;
constexpr size_t WS_WOUT = 26 * MiB;
constexpr size_t WS_XF8 = 60 * MiB;
constexpr size_t WS_MIXIN = 28 * MiB;
constexpr size_t WS_WD = 92 * MiB;
constexpr size_t WS_XBF = 124 * MiB;
constexpr size_t WS_R1 = 188 * MiB;
constexpr size_t WS_R2 = 332 * MiB;
constexpr size_t WS_QM = WS_R2, WS_KM = WS_R2 + 24 * MiB, WS_VTM = WS_R2 + 48 * MiB, WS_VTG = WS_R2 + 64 * MiB;
constexpr size_t WS_WGU = WS_R2 + 72 * MiB;
constexpr size_t WS_END = 460 * MiB;

constexpr int RING_BYTES = 131072;
constexpr int GIDX_OFF = 131072, GIDX_BYTES = 16384;
constexpr int LDS_BYTES = GIDX_OFF + GIDX_BYTES + 256;

__device__ __forceinline__ unsigned pk2(float lo, float hi) { f32x2 v = {lo, hi}; bf16x2_t b = __builtin_convertvector(v, bf16x2_t); return __builtin_bit_cast(unsigned, b); }
__device__ __forceinline__ bf16_t f2bf(float f) { return (bf16_t)(pk2(f, 0.f) & 0xffffu); }
__device__ __forceinline__ float bf2f(unsigned short h) { return __uint_as_float(((unsigned)h) << 16); }
__device__ __forceinline__ float bflo(unsigned w) { return __uint_as_float(w << 16); }
__device__ __forceinline__ float bfhi(unsigned w) { return __uint_as_float(w & 0xffff0000u); }
__device__ __forceinline__ float row16_max(float v) {
    v = fmaxf(v, __int_as_float(__builtin_amdgcn_update_dpp(0, __float_as_int(v), 0xB1, 0xF, 0xF, true)));
    v = fmaxf(v, __int_as_float(__builtin_amdgcn_update_dpp(0, __float_as_int(v), 0x4E, 0xF, 0xF, true)));
    v = fmaxf(v, __int_as_float(__builtin_amdgcn_update_dpp(0, __float_as_int(v), 0x141, 0xF, 0xF, true)));
    v = fmaxf(v, __int_as_float(__builtin_amdgcn_update_dpp(0, __float_as_int(v), 0x140, 0xF, 0xF, true)));
    return v;
}
__device__ __forceinline__ float row16_sum(float v) {
    v += __int_as_float(__builtin_amdgcn_update_dpp(0, __float_as_int(v), 0xB1, 0xF, 0xF, true));
    v += __int_as_float(__builtin_amdgcn_update_dpp(0, __float_as_int(v), 0x4E, 0xF, 0xF, true));
    v += __int_as_float(__builtin_amdgcn_update_dpp(0, __float_as_int(v), 0x141, 0xF, 0xF, true));
    v += __int_as_float(__builtin_amdgcn_update_dpp(0, __float_as_int(v), 0x140, 0xF, 0xF, true));
    return v;
}
__device__ __forceinline__ float wave_sum(float v) {
    v += __int_as_float(__builtin_amdgcn_update_dpp(0, __float_as_int(v), 0xB1, 0xF, 0xF, true));
    v += __int_as_float(__builtin_amdgcn_update_dpp(0, __float_as_int(v), 0x4E, 0xF, 0xF, true));
    v += __int_as_float(__builtin_amdgcn_update_dpp(0, __float_as_int(v), 0x141, 0xF, 0xF, true));
    v += __int_as_float(__builtin_amdgcn_update_dpp(0, __float_as_int(v), 0x140, 0xF, 0xF, true));
    const float r0 = __int_as_float(__builtin_amdgcn_readlane(__float_as_int(v), 0)), r1 = __int_as_float(__builtin_amdgcn_readlane(__float_as_int(v), 16));
    const float r2 = __int_as_float(__builtin_amdgcn_readlane(__float_as_int(v), 32)), r3 = __int_as_float(__builtin_amdgcn_readlane(__float_as_int(v), 48));
    return (r0 + r1) + (r2 + r3);
}

__device__ __forceinline__ void unpack8(const u32x4 w, float* v) { v[0] = bflo(w[0]); v[1] = bfhi(w[0]); v[2] = bflo(w[1]); v[3] = bfhi(w[1]); v[4] = bflo(w[2]); v[5] = bfhi(w[2]); v[6] = bflo(w[3]); v[7] = bfhi(w[3]); }
__device__ __forceinline__ u32x4 pack8(const float* v) { return (u32x4){pk2(v[0], v[1]), pk2(v[2], v[3]), pk2(v[4], v[5]), pk2(v[6], v[7])}; }
__device__ __forceinline__ unsigned cvt4_fp8(const f32x4 v) { int w = __builtin_amdgcn_cvt_pk_fp8_f32(v[0], v[1], 0, false); return (unsigned)__builtin_amdgcn_cvt_pk_fp8_f32(v[2], v[3], w, true); }
__device__ __forceinline__ void acc16_fp8(const u32x4 w, float* v, float sc) {
#pragma unroll
    for (int q = 0; q < 4; ++q) { const f32x2 a = __builtin_amdgcn_cvt_pk_f32_fp8((int)w[q], false), b = __builtin_amdgcn_cvt_pk_f32_fp8((int)w[q], true);
        v[4 * q] += a[0] * sc; v[4 * q + 1] += a[1] * sc; v[4 * q + 2] += b[0] * sc; v[4 * q + 3] += b[1] * sc; }
}
__device__ __forceinline__ void ln_row16(float* v, const float* gg, const float* bb) {
    float s = 0.f;
#pragma unroll
    for (int i = 0; i < 16; ++i) s += v[i];
    const float mean = wave_sum(s) * (1.0f / DM); float s2 = 0.f;
#pragma unroll
    for (int i = 0; i < 16; ++i) { v[i] -= mean; s2 += v[i] * v[i]; }
    const float rstd = __builtin_amdgcn_rsqf(wave_sum(s2) * (1.0f / DM) + LN_EPS);
#pragma unroll
    for (int i = 0; i < 16; ++i) v[i] = v[i] * rstd * gg[i] + bb[i];
}
__device__ __forceinline__ float fast_sigmoid(float x) { return __builtin_amdgcn_rcpf(1.f + __expf(-x)); }

namespace pg8 {
constexpr int BM = 256, BK = 64, HALF = 128, HTB = HALF * BK * 2, STAGE_BYTES = 8 * HTB, NXCD = 8, WGM = 8;
__host__ __device__ __forceinline__ int lds_byte(int r, int c) { const int st = (r >> 4) * 2 + (c >> 5), rr = r & 15, cc = c & 31, ob = rr * 64 + cc * 2; return st * 1024 + (ob ^ (((ob >> 9) & 1) << 5)); }
__host__ __device__ __forceinline__ void stage_rc(int b, int& R, int& C) { const int st = b / 1024, sb = b % 1024, swz = sb ^ (((sb >> 9) & 1) << 5); R = (st >> 1) * 16 + swz / 64; C = (st & 1) * 32 + (swz % 64) / 2; }

struct Unit { int pm, pn, e; };
struct Gemm { const bf16_t* A; const bf16_t* Bt; int lda, ldb, K; long strideA, strideB; int sw = 0, sx = 0; };

struct Order {
    int nM, nN, nE, nwg, G, c;
    __device__ __forceinline__ void init(int M, int N, int E, int G_, int c_) { nM = M / BM; nN = N / BM; nE = E; nwg = nM * nN * nE; G = G_; c = c_; }
    __device__ __forceinline__ bool next(int i, Unit& u) const {
        const long L = (long)i * G + c; if (L >= nwg) return false;
        int wgid = (int)L; { const int q = nwg / NXCD, r = nwg % NXCD, xcd = wgid % NXCD, off = wgid / NXCD; wgid = (xcd < r ? xcd * (q + 1) : r * (q + 1) + (xcd - r) * q) + off; }
        const int per = nM * nN; u.e = wgid / per; const int w = wgid % per;
        const int nig = WGM * nN, gid = w / nig, fm = gid * WGM, gsz = (nM - fm) < WGM ? (nM - fm) : WGM;
        u.pm = fm + ((w % nig) % gsz); u.pn = (w % nig) / gsz; return true;
    }
};

template <int NN>
struct OrderT {
    int G, c;
    __device__ __forceinline__ void init(int G_, int c_) { G = G_; c = c_; }
    __device__ __forceinline__ bool next(int i, Unit& u) const {
        constexpr int nM = NTOK / BM, nwg = nM * NN, q = nwg / NXCD, nig = WGM * NN;
        static_assert(nwg % NXCD == 0 && nM % WGM == 0, "OrderT: tile counts");
        const int L = i * G + c; if (L >= nwg) return false;
        const int w = (L % NXCD) * q + L / NXCD;
        u.e = 0; u.pm = (w / nig) * WGM + (w % nig) % WGM; u.pn = (w % nig) / WGM; return true;
    }
};


struct PanelOrder {
    int e, pm, nN;
    __device__ __forceinline__ void init(int bx, int nN_) { const int xcd = bx & 7, j = bx >> 3; e = xcd * 2 + (j >> 4); pm = j & 15; nN = nN_; }
    __device__ __forceinline__ bool next(int i, Unit& u) const { if (i >= nN) return false; u.e = e; u.pm = pm; u.pn = i; return true; }
};

template <class Epi, bool GATHER, class Sched, int GSTRIDE = BM, bool FP8 = false>
__device__ __forceinline__ void gemm_phase(const int tid, LAS unsigned char* lds, const LAS int* gidx, const Gemm g, const Sched& S, const Epi& E) {
    const int wid = __builtin_amdgcn_readfirstlane(tid >> 6), lane = tid & 63, wr = wid >> 2, wc = wid & 3, fr = lane & 15, fq = lane >> 4;
    int nt = g.K / BK; asm volatile("" : "+s"(nt));
    int Rs[2], Cs[2]; unsigned voffB[2], voffA[2][2];
#pragma unroll
    for (int i = 0; i < 2; ++i) { int R, C; stage_rc(tid * 16 + i * 8192, R, C); Rs[i] = R; Cs[i] = C; voffB[i] = (unsigned)(R * g.ldb + C) * 2u; }
    const size_t kstep = (size_t)(BK * 2);
    const size_t hstepB = (size_t)HALF * g.ldb * 2;
    const unsigned ldsw = (unsigned)wid * 1024u;
    const int aoff = lds_byte(wr * 64 + fr, FP8 ? fq * 16 : fq * 8), boff = lds_byte(wc * 32 + fr, FP8 ? fq * 16 : fq * 8);
    constexpr int KFS = FP8 ? 16 : 1024;
#define PG8_SA(b, h) (((b) * 2 + (h)) * HTB)
#define PG8_SB(b, h) ((4 + (b) * 2 + (h)) * HTB)
#define PG8_STAGE(bufoff, gptr, v0, v1) do { \
        __builtin_amdgcn_global_load_lds((const unsigned*)((gptr) + (v0)), (LAS unsigned*)(lds + (bufoff) + ldsw), 16, 0, 0); \
        __builtin_amdgcn_global_load_lds((const unsigned*)((gptr) + (v1)), (LAS unsigned*)(lds + (bufoff) + ldsw + 8192), 16, 0, 0); } while (0)
#define PG8_STA(bufoff, gptr, V, h) PG8_STAGE(bufoff, gptr, V[h][0], V[h][1])
#define PG8_STB(bufoff, gptr, h) PG8_STAGE(bufoff, (gptr) + (h) * hstepB, voffB[0], voffB[1])
#define PG8_LDA(dst, b, h) do { _Pragma("unroll") for (int m = 0; m < 4; ++m) { if constexpr (FP8) dst##8[m] = *(const LAS v8i_t*)(lds + PG8_SA(b, h) + aoff + m * 2048); \
        else { _Pragma("unroll") for (int k = 0; k < 2; ++k) dst[m][k] = *(const LAS bf16x8*)(lds + PG8_SA(b, h) + aoff + m * 2048 + k * KFS); } } } while (0)
#define PG8_LDB(dst, b, h) do { _Pragma("unroll") for (int n = 0; n < 2; ++n) { if constexpr (FP8) dst##8[n] = *(const LAS v8i_t*)(lds + PG8_SB(b, h) + boff + n * 2048); \
        else { _Pragma("unroll") for (int k = 0; k < 2; ++k) dst[n][k] = *(const LAS bf16x8*)(lds + PG8_SB(b, h) + boff + n * 2048 + k * KFS); } } } while (0)
#define PG8_MMA(ai, bj, At, Bt) do { __builtin_amdgcn_s_setprio(1); _Pragma("unroll") for (int m = 0; m < 4; ++m) _Pragma("unroll") for (int n = 0; n < 2; ++n) { \
        if constexpr (FP8) { acc[ai][bj][m][n] = __builtin_amdgcn_mfma_scale_f32_16x16x128_f8f6f4(Bt##8[n], At##8[m], acc[ai][bj][m][n], 0, 0, 0, g.sw, 0, g.sx); } \
        else { _Pragma("unroll") for (int k = 0; k < 2; ++k) acc[ai][bj][m][n] = __builtin_amdgcn_mfma_f32_16x16x32_bf16(Bt[n][k], At[m][k], acc[ai][bj][m][n], 0, 0, 0); } } \
        __builtin_amdgcn_s_setprio(0); } while (0)
#define PG8_WAIT_V(n) asm volatile("s_waitcnt vmcnt(" #n ")" ::: "memory")
#define PG8_WAIT_L(n) asm volatile("s_waitcnt lgkmcnt(" #n ")" ::: "memory")
#define PG8_BAR __builtin_amdgcn_s_barrier()
#define PG8_SCHED __builtin_amdgcn_sched_barrier(0)
#define PG8_BASEA(u) (GATHER ? (const char*)g.A : (const char*)g.A + ((size_t)(u).e * g.strideA + (size_t)(u).pm * BM * g.lda) * 2)
#define PG8_BASEB(u) ((const char*)g.Bt + ((size_t)(u).e * g.strideB + (size_t)(u).pn * BM * g.ldb) * 2)
#define PG8_VOFF(V, uidx) do { _Pragma("unroll") for (int h = 0; h < 2; ++h) _Pragma("unroll") for (int i = 0; i < 2; ++i) { \
        const int rr_ = h * HALF + Rs[i]; const int arow_ = GATHER ? gidx[(uidx) * GSTRIDE + rr_] : rr_; V[h][i] = (unsigned)(arow_ * g.lda + Cs[i]) * 2u; } } while (0)
    Unit cur, nxt; int ui = 0;
    if (!S.next(0, cur)) return;
    f32x4 acc[2][2][4][2];
#pragma unroll
    for (int a = 0; a < 2; ++a)
#pragma unroll
        for (int b = 0; b < 2; ++b)
#pragma unroll
            for (int m = 0; m < 4; ++m)
#pragma unroll
                for (int n = 0; n < 2; ++n) acc[a][b][m][n] = (f32x4){0.f, 0.f, 0.f, 0.f};
    bf16x8 At[4][2], B0[2][2], B1[2][2];
    v8i_t At8[4], B08[2], B18[2];
    const char* cA = PG8_BASEA(cur); const char* cB = PG8_BASEB(cur);
    PG8_VOFF(voffA, 0);
    PG8_STB(PG8_SB(0, 0), cB, 0); PG8_STB(PG8_SB(0, 1), cB, 1); PG8_STA(PG8_SA(0, 0), cA, voffA, 0); PG8_STA(PG8_SA(0, 1), cA, voffA, 1);
    if (wr == 1) PG8_BAR;
    PG8_WAIT_V(2); PG8_BAR;
    PG8_STB(PG8_SB(1, 0), cB + kstep, 0); PG8_STA(PG8_SA(1, 0), cA + kstep, voffA, 0); PG8_STB(PG8_SB(1, 1), cB + kstep, 1);
    PG8_WAIT_V(6); PG8_BAR;
    for (;;) {
        const bool has_next = S.next(ui + 1, nxt);
        const char* nA = has_next ? PG8_BASEA(nxt) : cA; const char* nB = has_next ? PG8_BASEB(nxt) : cB;
#pragma unroll 1
        for (int t = 0; t < nt; t += 2) {
            const bool last = (t == nt - 2);
            const char* a1 = cA + (size_t)(t + 1) * kstep;
            const char* a2 = last ? nA : cA + (size_t)(t + 2) * kstep; const char* b2 = last ? nB : cB + (size_t)(t + 2) * kstep;
            const char* a3 = a2 + kstep; const char* b3 = b2 + kstep;
            PG8_LDB(B0, 0, 0); PG8_LDB(B1, 0, 1); PG8_SCHED; PG8_LDA(At, 0, 0); PG8_STA(PG8_SA(1, 1), a1, voffA, 1);
            PG8_WAIT_V(8); PG8_WAIT_L(0); PG8_BAR; PG8_MMA(0, 0, At, B0); PG8_MMA(0, 1, At, B1); PG8_BAR; PG8_SCHED;
            if constexpr (GATHER) { if (last && has_next) { PG8_VOFF(voffA, ui + 1); } }
            PG8_LDA(At, 0, 1); PG8_STB(PG8_SB(0, 0), b2, 0); PG8_STB(PG8_SB(0, 1), b2, 1); PG8_STA(PG8_SA(0, 0), a2, voffA, 0);
            PG8_WAIT_V(8); PG8_WAIT_L(0); PG8_BAR; PG8_MMA(1, 0, At, B0); PG8_MMA(1, 1, At, B1); PG8_BAR; PG8_SCHED;
            PG8_LDB(B0, 1, 0); PG8_LDB(B1, 1, 1); PG8_SCHED; PG8_LDA(At, 1, 0); PG8_STA(PG8_SA(0, 1), a2, voffA, 1);
            PG8_WAIT_V(8); PG8_WAIT_L(0); PG8_BAR; PG8_MMA(0, 0, At, B0); PG8_MMA(0, 1, At, B1); PG8_BAR; PG8_SCHED;
            PG8_LDA(At, 1, 1); PG8_STB(PG8_SB(1, 0), b3, 0); PG8_STB(PG8_SB(1, 1), b3, 1); PG8_STA(PG8_SA(1, 0), a3, voffA, 0);
            PG8_WAIT_V(8); PG8_WAIT_L(0); PG8_BAR; PG8_MMA(1, 0, At, B0); PG8_MMA(1, 1, At, B1); PG8_BAR; PG8_SCHED;
        }
        if (wr == 0) PG8_BAR;
        E(acc, cur, wr, wc, fr, fq);
        if (!has_next) break;
#pragma unroll
        for (int a = 0; a < 2; ++a)
#pragma unroll
            for (int b = 0; b < 2; ++b)
#pragma unroll
                for (int m = 0; m < 4; ++m)
#pragma unroll
                    for (int n = 0; n < 2; ++n) acc[a][b][m][n] = (f32x4){0.f, 0.f, 0.f, 0.f};
        cur = nxt; cA = nA; cB = nB; ++ui;
        if (wr == 1) PG8_BAR;
    }
    PG8_WAIT_V(0);
    PG8_BAR;
#undef PG8_SA
#undef PG8_SB
#undef PG8_STAGE
#undef PG8_STA
#undef PG8_STB
#undef PG8_LDA
#undef PG8_LDB
#undef PG8_MMA
#undef PG8_WAIT_V
#undef PG8_WAIT_L
#undef PG8_BAR
#undef PG8_SCHED
#undef PG8_BASEA
#undef PG8_BASEB
#undef PG8_VOFF
}
}

#define EPI_ROWS_BEGIN _Pragma("unroll") for (int ai = 0; ai < 2; ++ai) _Pragma("unroll") for (int m = 0; m < 4; ++m) { const int rt = ai * 128 + wr * 64 + m * 16 + fr; const int row = u.pm * 256 + rt; (void)rt;
#define EPI_ROWS_END asm volatile("" ::: "memory"); }

__host__ __device__ __forceinline__ int perm32(int p) { return ((p >> 2) & 3) * 8 + ((p >> 4) & 1) * 4 + (p & 3); }
__device__ __forceinline__ float dpp_qx1(float v) { return __int_as_float(__builtin_amdgcn_update_dpp(0, __float_as_int(v), 0xB1, 0xF, 0xF, true)); }
__device__ __forceinline__ float dpp_qx2(float v) { return __int_as_float(__builtin_amdgcn_update_dpp(0, __float_as_int(v), 0x4E, 0xF, 0xF, true)); }
__device__ __forceinline__ f32x4 quad_transpose(f32x4 a, int p) {
    const bool o1 = p & 1, o2 = p & 2;
    { const float r0 = dpp_qx1(o1 ? a[0] : a[1]), r1 = dpp_qx1(o1 ? a[2] : a[3]); if (o1) { a[0] = r0; a[2] = r1; } else { a[1] = r0; a[3] = r1; } }
    { const float q0 = dpp_qx2(o2 ? a[0] : a[2]), q1 = dpp_qx2(o2 ? a[1] : a[3]); if (o2) { a[0] = q0; a[1] = q1; } else { a[2] = q0; a[3] = q1; } }
    return a;
}
__device__ __forceinline__ int vperm64(int s) { const int k = s & 63; return (s & ~63) | (32 * ((k >> 2) & 1) + 16 * (k >> 5) + 4 * ((k >> 3) & 3) + (k & 3)); }
__device__ __forceinline__ int vperm16(int s) { const int k = s & 15; return (s & ~15) | ((k & 3) | ((k & 4) << 1) | ((k & 8) >> 1)); }

struct EpiProj {
    bf16_t* proj; float* ssq_q; float* ssq_kv; unsigned char* Km; bf16_t* Vtg;
    const float* cosA; const float* sinA; const float* cosD; const float* sinD;
    __device__ __forceinline__ void operator()(const f32x4 (&acc)[2][2][4][2], const pg8::Unit& u, int wr, int wc, int fr0, int fq0) const {
        int fr = fr0, fq = fq0; asm volatile("" : "+v"(fr), "+v"(fq));
        const int pn = u.pn;
        const bool rp = pn >= 7 || (pn == 1 && wc == 0);
        const float* ct = (pn == 1) ? cosA : cosD; const float* st = (pn == 1) ? sinA : sinD; const int rw = (pn == 1) ? 16 : 32, ro = (pn == 1) ? fq * 4 : (wc & 1) * 16 + fq * 4;
#pragma unroll
        for (int ai = 0; ai < 2; ++ai) {
        f32x4 rc[4], rs[4];
        if (rp) {
#pragma unroll
            for (int m = 0; m < 4; ++m) { const size_t rr = (size_t)(u.pm * 256 + ai * 128 + wr * 64 + m * 16 + fr) * rw + ro; rc[m] = *(const f32x4*)(ct + rr); rs[m] = *(const f32x4*)(st + rr); }
        }
#pragma unroll
        for (int m = 0; m < 4; ++m) { const int rt = ai * 128 + wr * 64 + m * 16 + fr; const int row = u.pm * 256 + rt; (void)rt;
            bf16_t* prow = proj + (size_t)row * NPROJ + pn * 256 + wc * 32 + fq * 4;
            bf16_t* prow8 = proj + (size_t)row * NPROJ + pn * 256 + wc * 32 + fq * 8;
            if (pn >= 3 && pn <= 6) {
                const f32x4 a0 = acc[ai][0][m][0], a1 = acc[ai][0][m][1], g0 = acc[ai][1][m][0], g1 = acc[ai][1][m][1];
                f32x4 o0, o1;
                if (pn <= 4) { o0 = a0 * g0; o1 = a1 * g1; }
                else {
#pragma unroll
                    for (int j = 0; j < 4; ++j) { o0[j] = a0[j] * fast_sigmoid(g0[j]); o1[j] = a1[j] * fast_sigmoid(g1[j]); } }
                *(u32x4*)(proj + (size_t)row * NPROJ + (pn <= 4 ? PC_SCC : PC_CFA) + ((pn - 3) & 1) * 128 + wc * 32 + fq * 8) = (u32x4){pk2(o0[0], o0[1]), pk2(o0[2], o0[3]), pk2(o1[0], o1[1]), pk2(o1[2], o1[3])};
            } else if (pn == 0 || pn == 2) {
                float s = 0.f;
#pragma unroll
                for (int bj = 0; bj < 2; ++bj) { const f32x4 v0 = acc[ai][bj][m][0], v1 = acc[ai][bj][m][1];
                    s += (v0[0] * v0[0] + v0[1] * v0[1] + v0[2] * v0[2] + v0[3] * v0[3]) + (v1[0] * v1[0] + v1[1] * v1[1] + v1[2] * v1[2] + v1[3] * v1[3]);
                    *(u32x4*)(prow8 + bj * 128) = (u32x4){pk2(v0[0], v0[1]), pk2(v0[2], v0[3]), pk2(v1[0], v1[1]), pk2(v1[2], v1[3])}; }
                if (pn == 0) { s += __shfl_xor(s, 16); s += __shfl_xor(s, 32); if (fq == 0) ssq_q[(size_t)row * 4 + wc] = s; }
            } else if (pn == 1) {
                float s = 0.f;
                { const f32x4 v0 = acc[ai][0][m][0], v1 = acc[ai][0][m][1];
                  s += (v0[0] * v0[0] + v0[1] * v0[1] + v0[2] * v0[2] + v0[3] * v0[3]) + (v1[0] * v1[0] + v1[1] * v1[1] + v1[2] * v1[2] + v1[3] * v1[3]);
                  *(u32x4*)(prow8) = (u32x4){pk2(v0[0], v0[1]), pk2(v0[2], v0[3]), pk2(v1[0], v1[1]), pk2(v1[2], v1[3])}; }
                s += __shfl_xor(s, 16); s += __shfl_xor(s, 32); if (fq == 0) ssq_kv[(size_t)row * 4 + wc] = s;
                if (wc == 0) {
                    const f32x4 x1 = acc[ai][1][m][0], x2 = acc[ai][1][m][1];
                    const f32x4 c = rc[m], sn = rs[m];
                    const f32x4 o1 = x1 * c - x2 * sn, o2 = x2 * c + x1 * sn;
                    const u32x2 w12 = {cvt4_fp8(o1), cvt4_fp8(o2)};
                    const int b = row / SEQ, s_ = row % SEQ;
#pragma unroll
                    for (int h = 0; h < 4; ++h) *(u32x2*)(Km + ((size_t)(b * 4 + h) * SEQ + s_) * 96 + 64 + fq * 8) = w12;
                }
            } else if (pn == 7) {
                const int w = wc & 1;
                const f32x4 c = rc[m], sn = rs[m]; (void)w;
                const float sc = 0.125f * LOG2E;
#pragma unroll
                for (int bj = 0; bj < 2; ++bj) { const f32x4 x1 = acc[ai][bj][m][0], x2 = acc[ai][bj][m][1];
                    const f32x4 o1 = (x1 * c - x2 * sn) * sc, o2 = (x2 * c + x1 * sn) * sc;
                    *(u32x4*)(prow8 + bj * 128) = (u32x4){pk2(o1[0], o1[1]), pk2(o1[2], o1[3]), pk2(o2[0], o2[1]), pk2(o2[2], o2[3])}; }
            } else {
                const int w = wc & 1;
                const f32x4 c = rc[m], sn = rs[m]; (void)w;
                { const f32x4 x1 = acc[ai][0][m][0], x2 = acc[ai][0][m][1];
                  const f32x4 o1 = x1 * c - x2 * sn, o2 = x2 * c + x1 * sn;
                  *(u32x4*)(prow8) = (u32x4){pk2(o1[0], o1[1]), pk2(o1[2], o1[3]), pk2(o2[0], o2[1]), pk2(o2[2], o2[3])}; }
                const int b = row / SEQ, s_ = row % SEQ, p = fr & 3, sg = vperm16(s_ - p);
#pragma unroll
                for (int n = 0; n < 2; ++n) { const f32x4 v = quad_transpose(acc[ai][1][m][n], p); const int cv = wc * 32 + n * 16 + fq * 4 + p; const int kvh = cv >> 6, d = cv & 63;
                    *(u32x2*)(Vtg + ((size_t)(b * 2 + kvh) * 64 + d) * SEQ + sg) = (u32x2){pk2(v[0], v[1]), pk2(v[2], v[3])}; }
            }
        asm volatile("" ::: "memory"); }
        }
    }
};

struct EpiQup {
    unsigned char* Qm; const float* ssq_q; const float* cosA; const float* sinA;
    __device__ __forceinline__ void operator()(const f32x4 (&acc)[2][2][4][2], const pg8::Unit& u, int wr, int wc, int fr0, int fq0) const {
        int fr = fr0, fq = fq0; asm volatile("" : "+v"(fr), "+v"(fq));
        f32x4 sqv[2][4];
#pragma unroll
        for (int ai = 0; ai < 2; ++ai)
#pragma unroll
            for (int m = 0; m < 4; ++m) sqv[ai][m] = *(const f32x4*)(ssq_q + (size_t)(u.pm * 256 + ai * 128 + wr * 64 + m * 16 + fr) * 4);
        EPI_ROWS_BEGIN
            const f32x4 sq = sqv[ai][m];
            const float rstd = __builtin_amdgcn_rsqf((sq[0] + sq[1] + sq[2] + sq[3]) * (1.0f / 256.0f) + RMS_EPS);
            const int b = row / SEQ, s_ = row % SEQ;
#pragma unroll
            for (int bj = 0; bj < 2; ++bj) {
                const int g0 = u.pn * 256 + bj * 128 + wc * 32;
                if (g0 < 384) {
                    const int h = g0 / 96, j0 = g0 % 96;
                    unsigned char* qp = Qm + ((size_t)(b * 4 + h) * SEQ + s_) * 96 + j0 + fq * 8;
                    f32x4 x1 = acc[ai][bj][m][0] * (rstd * 8.0f), x2 = acc[ai][bj][m][1] * (rstd * 8.0f);
                    if (j0 == 64) {
                        const f32x4 c = *(const f32x4*)(cosA + (size_t)row * 16 + fq * 4), sn = *(const f32x4*)(sinA + (size_t)row * 16 + fq * 4);
                        const f32x4 o1 = x1 * c - x2 * sn, o2 = x2 * c + x1 * sn; x1 = o1; x2 = o2;
                    }
                    *(u32x2*)qp = (u32x2){cvt4_fp8(x1), cvt4_fp8(x2)};
                }
            }
        EPI_ROWS_END
    }
};

struct EpiKVup {
    unsigned char* Km; unsigned char* Vtm; const float* ssq_kv;
    __device__ __forceinline__ void operator()(const f32x4 (&acc)[2][2][4][2], const pg8::Unit& u, int wr, int wc, int fr0, int fq0) const {
        int fr = fr0, fq = fq0; asm volatile("" : "+v"(fr), "+v"(fq));
        f32x4 sqv[2][4];
#pragma unroll
        for (int ai = 0; ai < 2; ++ai)
#pragma unroll
            for (int m = 0; m < 4; ++m) sqv[ai][m] = *(const f32x4*)(ssq_kv + (size_t)(u.pm * 256 + ai * 128 + wr * 64 + m * 16 + fr) * 4);
        EPI_ROWS_BEGIN
            const f32x4 sq = sqv[ai][m];
            const float rstd = __builtin_amdgcn_rsqf((sq[0] + sq[1] + sq[2] + sq[3]) * (1.0f / 128.0f) + RMS_EPS);
            const int b = row / SEQ, s_ = row % SEQ;
#pragma unroll
            for (int bj = 0; bj < 2; ++bj) {
                const int h = u.pn * 2 + bj;
                if (wc < 2) {
                    unsigned char* kp = Km + ((size_t)(b * 4 + h) * SEQ + s_) * 96 + wc * 32 + fq * 8;
                    *(u32x2*)kp = (u32x2){cvt4_fp8(acc[ai][bj][m][0] * rstd), cvt4_fp8(acc[ai][bj][m][1] * rstd)};
                } else {
                    const int p = fr & 3, sg = vperm64(s_ - p);
#pragma unroll
                    for (int n = 0; n < 2; ++n) { const f32x4 v = quad_transpose(acc[ai][bj][m][n] * rstd, p); const int d = (wc - 2) * 32 + n * 16 + fq * 4 + p;
                        *(unsigned*)(Vtm + ((size_t)(b * 4 + h) * 64 + d) * SEQ + sg) = cvt4_fp8(v); }
                }
            }
        EPI_ROWS_END
    }
};

struct EpiOut {
    bf16_t* xb;
    __device__ __forceinline__ void operator()(const f32x4 (&acc)[2][2][4][2], const pg8::Unit& u, int wr, int wc, int fr0, int fq0) const {
        int fr = fr0, fq = fq0; asm volatile("" : "+v"(fr), "+v"(fq));
        u32x4 xr[2][4][2];
#pragma unroll
        for (int ai = 0; ai < 2; ++ai)
#pragma unroll
            for (int m = 0; m < 4; ++m)
#pragma unroll
                for (int bj = 0; bj < 2; ++bj) xr[ai][m][bj] = *(const u32x4*)(xb + (size_t)(u.pm * 256 + ai * 128 + wr * 64 + m * 16 + fr) * DM + u.pn * 256 + wc * 32 + fq * 8 + bj * 128);
        EPI_ROWS_BEGIN
            bf16_t* xp = xb + (size_t)row * DM + u.pn * 256 + wc * 32 + fq * 8;
#pragma unroll
            for (int bj = 0; bj < 2; ++bj) { const u32x4 x4 = xr[ai][m][bj]; const f32x4 a0 = acc[ai][bj][m][0], a1 = acc[ai][bj][m][1];
                *(u32x4*)(xp + bj * 128) = (u32x4){pk2(bflo(x4[0]) * ALPHA + a0[0], bfhi(x4[0]) * ALPHA + a0[1]), pk2(bflo(x4[1]) * ALPHA + a0[2], bfhi(x4[1]) * ALPHA + a0[3]),
                                                   pk2(bflo(x4[2]) * ALPHA + a1[0], bfhi(x4[2]) * ALPHA + a1[1]), pk2(bflo(x4[3]) * ALPHA + a1[2], bfhi(x4[3]) * ALPHA + a1[3])}; }
        EPI_ROWS_END
    }
};

struct EpiGateUp {
    unsigned char* hid8;
    __device__ __forceinline__ void operator()(const f32x4 (&acc)[2][2][4][2], const pg8::Unit& u, int wr, int wc, int fr0, int fq0) const {
        int fr = fr0, fq = fq0; asm volatile("" : "+v"(fr), "+v"(fq));
        EPI_ROWS_BEGIN
            unsigned char* hp = hid8 + ((size_t)u.e * EROWS + row) * FF + u.pn * 128 + wc * 32 + fq * 8;
            f32x4 o4[2];
#pragma unroll
            for (int n = 0; n < 2; ++n) { const f32x4 g = acc[ai][0][m][n], up = acc[ai][1][m][n];
                f32x4 e, r;
#pragma unroll
                for (int j = 0; j < 4; ++j) e[j] = __builtin_amdgcn_exp2f(-g[j]);
                const f32x4 d = e + 1.0f;
#pragma unroll
                for (int j = 0; j < 4; ++j) r[j] = __builtin_amdgcn_rcpf(d[j]);
                o4[n] = (g * up) * r; }
            int w0 = __builtin_amdgcn_cvt_pk_fp8_f32(o4[0][0], o4[0][1], 0, false); w0 = __builtin_amdgcn_cvt_pk_fp8_f32(o4[0][2], o4[0][3], w0, true);
            int w1 = __builtin_amdgcn_cvt_pk_fp8_f32(o4[1][0], o4[1][1], 0, false); w1 = __builtin_amdgcn_cvt_pk_fp8_f32(o4[1][2], o4[1][3], w1, true);
            *(u32x2*)hp = (u32x2){(unsigned)w0, (unsigned)w1};
        EPI_ROWS_END
    }
};

struct EpiDown {
    unsigned char* slab8; const LAS float* gate_l;
    __device__ __forceinline__ void operator()(const f32x4 (&acc)[2][2][4][2], const pg8::Unit& u, int wr, int wc, int fr0, int fq0) const {
        int fr = fr0, fq = fq0; asm volatile("" : "+v"(fr), "+v"(fq));
        EPI_ROWS_BEGIN
            const float gt = gate_l[rt] * 64.0f;
            unsigned char* sp = slab8 + ((size_t)u.e * EROWS + row) * DM + (u.pn * 16 + wc * 4 + fq) * 16;
            unsigned w[4];
#pragma unroll
            for (int bj = 0; bj < 2; ++bj) { const f32x4 v0 = acc[ai][bj][m][0] * gt, v1 = acc[ai][bj][m][1] * gt;
                int a = __builtin_amdgcn_cvt_pk_fp8_f32(v0[0], v0[1], 0, false); a = __builtin_amdgcn_cvt_pk_fp8_f32(v0[2], v0[3], a, true);
                int b = __builtin_amdgcn_cvt_pk_fp8_f32(v1[0], v1[1], 0, false); b = __builtin_amdgcn_cvt_pk_fp8_f32(v1[2], v1[3], b, true);
                w[2 * bj] = (unsigned)a; w[2 * bj + 1] = (unsigned)b; }
            *(u32x4*)sp = (u32x4){w[0], w[1], w[2], w[3]};
        EPI_ROWS_END
    }
};

__device__ __forceinline__ int crow(int r, int hi) { return (r & 3) + 8 * (r >> 2) + 4 * hi; }

__device__ __forceinline__ float max3f(float a, float b, float c) { float r; asm("v_max3_f32 %0, %1, %2, %3" : "=v"(r) : "v"(a), "v"(b), "v"(c)); return r; }
#define SBAR() __builtin_amdgcn_sched_barrier(0)

template <int DK, bool WIN>
__device__ __forceinline__ void attn_unit(const int tid, LAS unsigned char* lds, const bf16_t* Qw, int qstride, const bf16_t* Kb, int kstride, const bf16_t* Vt,
                                          bf16_t* Ow, int ostride, int qpos0, int t_lo, int t_hi, float sink_l2) {
    constexpr int KROW = DK * 2, KT = 64 * KROW, VT = 8192, NS = DK / 16, NQK = 2 * NS, CPR = DK / 8, NKP = KT / 1024, NP = (NKP > 8 ? 2 : 1) + 1, VBASE = 3 * KT;
    constexpr float THR = 8.0f;
    const int lane = tid & 63, r32 = lane & 31, hi = lane >> 5, wid = __builtin_amdgcn_readfirstlane(tid >> 6);
    bf16x8 qr[NS];
#pragma unroll
    for (int s = 0; s < NS; ++s) qr[s] = *(const bf16x8*)(Qw + (size_t)r32 * qstride + s * 16 + hi * 8);
    const int kp0 = wid, kp1 = (wid + 8 < NKP) ? wid + 8 : wid;
    int koff0, koff1, voff;
    { const int L0 = kp0 * 64 + lane, r0 = L0 / CPR, c0 = L0 % CPR, f0 = (DK == 96) ? ((r0 >> 2) & 3) : ((r0 >> 1) & 7); koff0 = r0 * kstride + ((c0 ^ f0) * 8);
      const int L1 = kp1 * 64 + lane, r1 = L1 / CPR, c1 = L1 % CPR, f1 = (DK == 96) ? ((r1 >> 2) & 3) : ((r1 >> 1) & 7); koff1 = r1 * kstride + ((c1 ^ f1) * 8);
      const int Lv = wid * 64 + lane, dv = Lv >> 3, cv = Lv & 7; voff = dv * SEQ + ((cv ^ ((dv >> 1) & 7)) * 8); }
#define AT_DMA(tk, tv, sk, sv) do { const int tk_ = (tk) < t_hi ? (tk) : t_hi - 1, tv_ = (tv) < t_hi ? (tv) : t_hi - 1; \
        __builtin_amdgcn_global_load_lds((const unsigned*)(Kb + (size_t)tk_ * 64 * kstride + koff0), (LAS unsigned*)(lds + (sk) * KT + kp0 * 1024), 16, 0, 0); \
        if (NP == 3) __builtin_amdgcn_global_load_lds((const unsigned*)(Kb + (size_t)tk_ * 64 * kstride + koff1), (LAS unsigned*)(lds + (sk) * KT + kp1 * 1024), 16, 0, 0); \
        __builtin_amdgcn_global_load_lds((const unsigned*)(Vt + (size_t)tv_ * 64 + voff), (LAS unsigned*)(lds + VBASE + (sv) * VT + wid * 1024), 16, 0, 0); } while (0)
#define AT_WAITBAR(n) do { asm volatile("s_waitcnt vmcnt(%0)" :: "n"(n) : "memory"); __builtin_amdgcn_s_barrier(); asm volatile("" ::: "memory"); } while (0)
    int kaddr[NS], vaddr[4];
    { const int fk = (DK == 96) ? ((r32 >> 2) & 3) : ((r32 >> 1) & 7), fv = (r32 >> 1) & 7;
#pragma unroll
      for (int s = 0; s < NS; ++s) kaddr[s] = r32 * KROW + (((2 * s + hi) ^ fk) * 16);
#pragma unroll
      for (int q = 0; q < 4; ++q) vaddr[q] = VBASE + r32 * 128 + (((2 * q + hi) ^ fv) * 16); }
#define AT_LDK(ko, i) (*(const LAS bf16x8*)(lds + (ko) + (DK == 96 ? kaddr[((i) >> 1) & 1] + 64 * ((i) >> 2) : kaddr[(i) >> 1]) + ((i) & 1) * 32 * KROW))
#define AT_LDV(dst, vo, j) do { dst = *(const LAS bf16x8*)(lds + (vo) + vaddr[(j) >> 1] + ((j) & 1) * 32 * 128); } while (0)
#define AT_MASK(X0, X1, t) do { if (WIN) { \
        if (64 * (t) > qpos0 + 159 || 64 * (t) + 63 < qpos0 - 128) {     \
            _Pragma("unroll") for (int r = 0; r < 16; ++r) { X0[r] = -INFINITY; X1[r] = -INFINITY; } } \
        else if (!(qpos0 + 31 - 64 * (t) <= 128 && 64 * (t) + 63 - qpos0 <= 128)) {     \
            const int lo_ = qpos0 + r32 - 128 - ((t) * 64 + 4 * hi);     \
            _Pragma("unroll") for (int r = 0; r < 16; ++r) { const unsigned u0_ = (unsigned)((r & 3) + 8 * (r >> 2) - lo_); \
                if (u0_ > 256u) X0[r] = -INFINITY; if (u0_ + 32u > 256u) X1[r] = -INFINITY; } } } } while (0)
#define AT_HQ(X0, X1, h) do { if ((h) < 8) { X0[2 * ((h) & 7)] = __builtin_amdgcn_exp2f(X0[2 * ((h) & 7)]); X0[2 * ((h) & 7) + 1] = __builtin_amdgcn_exp2f(X0[2 * ((h) & 7) + 1]); pw[0][(h) & 7] = pk2(X0[2 * ((h) & 7)], X0[2 * ((h) & 7) + 1]); } \
        else { X1[2 * ((h) & 7)] = __builtin_amdgcn_exp2f(X1[2 * ((h) & 7)]); X1[2 * ((h) & 7) + 1] = __builtin_amdgcn_exp2f(X1[2 * ((h) & 7) + 1]); pw[1][(h) & 7] = pk2(X1[2 * ((h) & 7)], X1[2 * ((h) & 7) + 1]); } } while (0)
#define AT_PB(j) __builtin_bit_cast(bf16x8, (u32x4){pw[(j) >> 2][4 * (((j) >> 1) & 1)], pw[(j) >> 2][4 * (((j) >> 1) & 1) + 1], pw[(j) >> 2][4 * (((j) >> 1) & 1) + 2], pw[(j) >> 2][4 * (((j) >> 1) & 1) + 3]})
    float m_ref = 0.f, l_run = 0.f;
    f32x16 ot[2]; ot[0] = f32x16{}; ot[1] = f32x16{};
    f32x16 pA0, pA1, pB0, pB1;
    f32x16 negm;
    unsigned pw[2][8];
#define AT_REGION_A(X0, X1, N0, N1, ko, vo) do { bf16x8 kf[NQK]; kf[0] = AT_LDK(ko, 0); kf[1] = AT_LDK(ko, 1); kf[2] = AT_LDK(ko, 2); kf[3] = AT_LDK(ko, 3); \
        SBAR(); \
        _Pragma("unroll") for (int i = 0; i < NQK; ++i) { \
            if (i + 4 < NQK) kf[i + 4] = AT_LDK(ko, i + 4); else AT_LDV(vf[i + 4 - NQK], vo, i + 4 - NQK); \
            if ((i & 1) == 0) N0 = __builtin_amdgcn_mfma_f32_32x32x16_bf16(kf[i], qr[i >> 1], i < 2 ? negm : N0, 0, 0, 0); \
            else N1 = __builtin_amdgcn_mfma_f32_32x32x16_bf16(kf[i], qr[i >> 1], i < 2 ? negm : N1, 0, 0, 0); \
            if (i < 16 - NQK) { AT_HQ(X0, X1, 2 * i); AT_HQ(X0, X1, 2 * i + 1); } else { AT_HQ(X0, X1, i + 16 - NQK); } \
            SBAR(); } } while (0)
#define AT_REGION_B(X0, X1, N0, N1, vo, DOMAX) do { \
        float sa_ = 0.f, sb_ = 0.f, sc_ = 0.f, sd_ = 0.f; \
        _Pragma("unroll") for (int j = 0; j < 8; ++j) { \
            if (j + 4 < 8) AT_LDV(vf[j + 4], vo, j + 4); \
            ot[j & 1] = __builtin_amdgcn_mfma_f32_32x32x16_bf16(vf[j], AT_PB(j), ot[j & 1], 0, 0, 0); \
            if (j < 4) { sa_ += X0[4 * j]; sb_ += X0[4 * j + 1]; sc_ += X0[4 * j + 2]; sd_ += X0[4 * j + 3]; } else { sa_ += X1[4 * (j - 4)]; sb_ += X1[4 * (j - 4) + 1]; sc_ += X1[4 * (j - 4) + 2]; sd_ += X1[4 * (j - 4) + 3]; } \
            if (DOMAX && !WIN) { if (j == 2) { mxa = max3f(N0[0], N0[1], N1[0]); mxb = max3f(N0[2], N0[3], N1[1]); mxa = max3f(mxa, N1[2], N1[3]); } \
                if (j == 3) { mxa = max3f(mxa, N0[4], N0[5]); mxb = max3f(mxb, N0[6], N0[7]); mxa = max3f(mxa, N1[4], N1[5]); } \
                if (j == 4) { mxb = max3f(mxb, N1[6], N1[7]); mxa = max3f(mxa, N0[8], N0[9]); mxb = max3f(mxb, N0[10], N0[11]); } \
                if (j == 5) { mxa = max3f(mxa, N1[8], N1[9]); mxb = max3f(mxb, N1[10], N1[11]); mxa = max3f(mxa, N0[12], N0[13]); } \
                if (j == 6) { mxb = max3f(mxb, N0[14], N0[15]); mxa = max3f(mxa, N1[12], N1[13]); } \
                if (j == 7) { mxb = max3f(mxb, N1[14], N1[15]); } } \
            SBAR(); } \
        l_run += (sa_ + sb_) + (sc_ + sd_); } while (0)
#define AT_ROWMAX_ALL(X0, X1) do { mxa = max3f(X0[0], X0[1], X1[0]); mxb = max3f(X0[2], X0[3], X1[1]); mxa = max3f(mxa, X1[2], X1[3]); \
        _Pragma("unroll") for (int r = 4; r < 16; r += 4) { mxa = max3f(mxa, X0[r], X0[r + 1]); mxb = max3f(mxb, X0[r + 2], X0[r + 3]); mxa = max3f(mxa, X1[r], X1[r + 1]); mxb = max3f(mxb, X1[r + 2], X1[r + 3]); } } while (0)
#define AT_RM_FINISH(rm) do { rm = fmaxf(mxa, mxb); auto rr_ = __builtin_amdgcn_permlane32_swap(__float_as_uint(rm), __float_as_uint(rm), false, false); rm = fmaxf(__uint_as_float(rr_[0]), __uint_as_float(rr_[1])); } while (0)
#define AT_ROT() do { const int t_ = s0; s0 = s1; s1 = s2; s2 = t_; } while (0)
#define AT_BODY(X0, X1, N0, N1, T) do { float mxa = 0.f, mxb = 0.f, rm_; bf16x8 vf[8]; \
        AT_DMA((T) + 3, (T) + 2, s0, s2); \
        AT_REGION_A(X0, X1, N0, N1, s1 * KT, s0 * VT); \
        AT_REGION_B(X0, X1, N0, N1, s0 * VT, true); \
        if (WIN) { AT_MASK(N0, N1, (T) + 1); AT_ROWMAX_ALL(N0, N1); } \
        AT_RM_FINISH(rm_); \
        if (__any(rm_ > THR)) { const float dl_ = fmaxf(rm_, 0.f); m_ref += dl_; const float f_ = __builtin_amdgcn_exp2f(-dl_); l_run *= f_; \
            _Pragma("unroll") for (int r = 0; r < 16; ++r) { N0[r] -= dl_; N1[r] -= dl_; ot[0][r] *= f_; ot[1][r] *= f_; negm[r] = -m_ref; } } \
        AT_WAITBAR(NP); AT_ROT(); } while (0)
    int s0 = 0, s1 = 1, s2 = 2;
    AT_DMA(t_lo, t_lo, 0, 0); AT_DMA(t_lo + 1, t_lo + 1, 1, 1); AT_DMA(t_lo + 2, t_lo + 2, 2, 2);
    AT_WAITBAR(2 * NP);
    {
#pragma unroll
        for (int i = 0; i < NQK; ++i) { const bf16x8 kf = AT_LDK(0, i);
            if ((i & 1) == 0) pA0 = __builtin_amdgcn_mfma_f32_32x32x16_bf16(kf, qr[i >> 1], i < 2 ? f32x16{} : pA0, 0, 0, 0);
            else pA1 = __builtin_amdgcn_mfma_f32_32x32x16_bf16(kf, qr[i >> 1], i < 2 ? f32x16{} : pA1, 0, 0, 0); }
        asm volatile("s_nop 7\n\ts_nop 7" : "+v"(pA0), "+v"(pA1));
        AT_MASK(pA0, pA1, t_lo);
        float mxa, mxb, rm; AT_ROWMAX_ALL(pA0, pA1); AT_RM_FINISH(rm);
        const float ref = (rm == -INFINITY) ? 0.f : rm; m_ref = ref;
#pragma unroll
        for (int r = 0; r < 16; ++r) { pA0[r] -= ref; pA1[r] -= ref; negm[r] = -ref; }
    }
    AT_WAITBAR(NP);
    int t = t_lo;
    for (; t + 2 < t_hi; t += 2) { AT_BODY(pA0, pA1, pB0, pB1, t); AT_BODY(pB0, pB1, pA0, pA1, t + 1); }
    AT_BODY(pA0, pA1, pB0, pB1, t);
    {
        float mxa = 0.f, mxb = 0.f; (void)mxa; (void)mxb; bf16x8 vf[8];
        AT_LDV(vf[0], s0 * VT, 0); AT_LDV(vf[1], s0 * VT, 1); AT_LDV(vf[2], s0 * VT, 2); AT_LDV(vf[3], s0 * VT, 3);
#pragma unroll
        for (int h = 0; h < 16; ++h) AT_HQ(pB0, pB1, h);
        AT_REGION_B(pB0, pB1, pA0, pA1, s0 * VT, false);
        AT_WAITBAR(0);
    }
#undef AT_DMA
#undef AT_WAITBAR
#undef AT_LDK
#undef AT_LDV
#undef AT_MASK
#undef AT_HQ
#undef AT_PB
#undef AT_REGION_A
#undef AT_REGION_B
#undef AT_ROWMAX_ALL
#undef AT_RM_FINISH
#undef AT_ROT
#undef AT_BODY
    { auto rr = __builtin_amdgcn_permlane32_swap(__float_as_uint(l_run), __float_as_uint(l_run), false, false); l_run = __uint_as_float(rr[0]) + __uint_as_float(rr[1]); }
    if (WIN) l_run += __builtin_amdgcn_exp2f(sink_l2 - m_ref);
    const float inv = __builtin_amdgcn_rcpf(l_run);
    int lane2 = lane; asm volatile("" : "+v"(lane2));
    bf16_t* op = Ow + (size_t)(lane2 & 31) * ostride + 4 * (lane2 >> 5);
#pragma unroll
    for (int db = 0; db < 2; ++db)
#pragma unroll
        for (int g = 0; g < 4; ++g)
            *(u32x2*)(op + db * 32 + 8 * g) = (u32x2){pk2(ot[db][4 * g] * inv, ot[db][4 * g + 1] * inv), pk2(ot[db][4 * g + 2] * inv, ot[db][4 * g + 3] * inv)};
}

__device__ __forceinline__ v8i_t mk8(const u32x4 a, const u32x4 b) { return (v8i_t){(int)a[0], (int)a[1], (int)a[2], (int)a[3], (int)b[0], (int)b[1], (int)b[2], (int)b[3]}; }
#define F8_MMA(A, B, C, SB) __builtin_amdgcn_mfma_scale_f32_32x32x64_f8f6f4(A, B, C, 0, 0, 0, 0x7F7F7F7F, 0, SB)

__device__ __forceinline__ void attn_mla_f8(const int tid, LAS unsigned char* lds, const unsigned char* Qw, const unsigned char* Kb, const unsigned char* Vt, bf16_t* Ow, int ostride) {
    constexpr int KT = 6144, VT = 4096, VBASE = 3 * KT, NT = SEQ / 64, NP = 2;
    constexpr float THR = 8.0f, BIAS = 5.0f;
    constexpr int SQ = 0x7C7C7C7C;
    const int lane = tid & 63, r32 = lane & 31, hi = lane >> 5, wid = __builtin_amdgcn_readfirstlane(tid >> 6);
    v8i_t q0, q1;
    { const unsigned char* qp = Qw + (size_t)r32 * 96;
      q0 = mk8(*(const u32x4*)(qp + 32 * hi), *(const u32x4*)(qp + 32 * hi + 16));
      const u32x4 c = *(const u32x4*)(qp + 64), d = *(const u32x4*)(qp + 80); q1 = mk8(c, d); if (hi) q1 = (v8i_t){0, 0, 0, 0, 0, 0, 0, 0}; }
    const bool aK = wid < 6, bV = wid < 2;
    const unsigned char* pa; const unsigned char* pb;
    { const int L = wid * 64 + lane, row = L / 6, c = L % 6; const int ok = row * 96 + ((c ^ ((row >> 3) & 1)) * 16);
      const int Lv = (aK ? 0 : wid - 6) * 64 + lane, dv = Lv >> 2, cv = Lv & 3; const int ov = dv * SEQ + ((cv ^ ((dv >> 2) & 3)) * 16);
      const int Lw = (wid + 2) * 64 + lane, dw = (Lw >> 2) & 63, cw = Lw & 3; const int ow = dw * SEQ + ((cw ^ ((dw >> 2) & 3)) * 16);
      pa = aK ? Kb + ok : Vt + ov; pb = bV ? Vt + ow : pa; }
    const int dstA0 = aK ? wid * 1024 : VBASE + (wid - 6) * 1024, dstB0 = bV ? VBASE + (wid + 2) * 1024 : dstA0;
    const int stepA = aK ? KT : VT, stepB = bV ? VT : stepA;
    const int incA = aK ? KT : 64, incB = bV ? 64 : incA;
#define F8_DMA(tk, tv, sk, sv) do { \
        __builtin_amdgcn_global_load_lds((const unsigned*)pa, (LAS unsigned*)(lds + dstA0 + (aK ? (sk) : (sv)) * stepA), 16, 0, 0); \
        __builtin_amdgcn_global_load_lds((const unsigned*)pb, (LAS unsigned*)(lds + dstB0 + (bV ? (sv) : (aK ? (sk) : (sv))) * stepB), 16, 0, 0); \
        pa += incA; pb += incB; } while (0)
#define F8_WAITBAR(n) do { asm volatile("s_waitcnt vmcnt(%0) lgkmcnt(0)" :: "n"(n) : "memory"); __builtin_amdgcn_s_barrier(); asm volatile("" ::: "memory"); } while (0)
    const int fk = (r32 >> 3) & 1, fv = (r32 >> 2) & 3;
    const int ka0 = r32 * 96 + (((2 * hi) ^ fk) * 16), ka1 = r32 * 96 + ((4 ^ fk) * 16), va0 = VBASE + r32 * 64 + (((2 * hi) ^ fv) * 16);
#define F8_LDK(ko, kb, c) mk8(*(const LAS u32x4*)(lds + (ko) + ((c) ? ka1 : ka0) + (kb) * 3072), *(const LAS u32x4*)(lds + (ko) + (((c) ? ka1 : ka0) ^ 16) + (kb) * 3072))
#define F8_LDV(vo, db) mk8(*(const LAS u32x4*)(lds + (vo) + va0 + (db) * 2048), *(const LAS u32x4*)(lds + (vo) + (va0 ^ 16) + (db) * 2048))
#define F8_HQ(X0, X1, h) do { if ((h) < 8) { X0[2 * (h)] = __builtin_amdgcn_exp2f(X0[2 * (h)]); X0[2 * (h) + 1] = __builtin_amdgcn_exp2f(X0[2 * (h) + 1]); \
            pw[(h) >> 1] = __builtin_amdgcn_cvt_pk_fp8_f32(X0[2 * (h)], X0[2 * (h) + 1], pw[(h) >> 1], ((h) & 1) != 0); } \
        else { X1[2 * ((h) - 8)] = __builtin_amdgcn_exp2f(X1[2 * ((h) - 8)]); X1[2 * ((h) - 8) + 1] = __builtin_amdgcn_exp2f(X1[2 * ((h) - 8) + 1]); \
            pw[4 + (((h) - 8) >> 1)] = __builtin_amdgcn_cvt_pk_fp8_f32(X1[2 * ((h) - 8)], X1[2 * ((h) - 8) + 1], pw[4 + (((h) - 8) >> 1)], ((h) & 1) != 0); } } while (0)
#define F8_HQ2(X0, X1, h) do { \
        if ((h) < 8) { X0[2 * (h)] = __builtin_amdgcn_exp2f(X0[2 * (h)]); X0[2 * (h) + 1] = __builtin_amdgcn_exp2f(X0[2 * (h) + 1]); X0[2 * (h) + 2] = __builtin_amdgcn_exp2f(X0[2 * (h) + 2]); X0[2 * (h) + 3] = __builtin_amdgcn_exp2f(X0[2 * (h) + 3]); \
            asm volatile("" : "+v"(X0[2 * (h)]), "+v"(X0[2 * (h) + 1]), "+v"(X0[2 * (h) + 2]), "+v"(X0[2 * (h) + 3])); \
            pw[(h) >> 1] = __builtin_amdgcn_cvt_pk_fp8_f32(X0[2 * (h)], X0[2 * (h) + 1], pw[(h) >> 1], false); pw[(h) >> 1] = __builtin_amdgcn_cvt_pk_fp8_f32(X0[2 * (h) + 2], X0[2 * (h) + 3], pw[(h) >> 1], true); } \
        else { X1[2 * ((h) - 8)] = __builtin_amdgcn_exp2f(X1[2 * ((h) - 8)]); X1[2 * ((h) - 8) + 1] = __builtin_amdgcn_exp2f(X1[2 * ((h) - 8) + 1]); X1[2 * ((h) - 8) + 2] = __builtin_amdgcn_exp2f(X1[2 * ((h) - 8) + 2]); X1[2 * ((h) - 8) + 3] = __builtin_amdgcn_exp2f(X1[2 * ((h) - 8) + 3]); \
            asm volatile("" : "+v"(X1[2 * ((h) - 8)]), "+v"(X1[2 * ((h) - 8) + 1]), "+v"(X1[2 * ((h) - 8) + 2]), "+v"(X1[2 * ((h) - 8) + 3])); \
            pw[4 + (((h) - 8) >> 1)] = __builtin_amdgcn_cvt_pk_fp8_f32(X1[2 * ((h) - 8)], X1[2 * ((h) - 8) + 1], pw[4 + (((h) - 8) >> 1)], false); \
            pw[4 + (((h) - 8) >> 1)] = __builtin_amdgcn_cvt_pk_fp8_f32(X1[2 * ((h) - 8) + 2], X1[2 * ((h) - 8) + 3], pw[4 + (((h) - 8) >> 1)], true); } } while (0)
    float m_ref = 0.f;
    f32x16 ot0 = f32x16{}, ot1 = f32x16{};
    f32x4 lacc = {0.f, 0.f, 0.f, 0.f};
    f32x16 pA0, pA1, pB0, pB1, negm;
    int pw[8] = {0, 0, 0, 0, 0, 0, 0, 0};
    const int o1_ = (((lane & 15) == 0 && ((lane >> 4) & 1) == 0) || ((lane & 15) == 1 && ((lane >> 4) & 1) == 1)) ? 0x38383838 : 0;
    const v8i_t ones8 = {o1_, o1_, o1_, o1_, o1_, o1_, o1_, o1_};
#define F8_PIN(V) asm volatile("" : "+v"(V))
#define F8_REGION_A(X0, X1, N0, N1, vo) do { \
        SBAR(); \
        N0 = F8_MMA(kf00, q0, negm, SQ); F8_PIN(N0); F8_HQ2(X0, X1, 0); F8_HQ2(X0, X1, 2); SBAR(); \
        N1 = F8_MMA(kf10, q0, negm, SQ); F8_PIN(N1); vf0 = F8_LDV(vo, 0); F8_HQ2(X0, X1, 4); F8_HQ2(X0, X1, 6); SBAR(); \
        N0 = F8_MMA(kf01, q1, N0, SQ); F8_PIN(N0); vf1 = F8_LDV(vo, 1); F8_HQ2(X0, X1, 8); F8_HQ2(X0, X1, 10); SBAR(); \
        N1 = F8_MMA(kf11, q1, N1, SQ); F8_PIN(N1); F8_HQ2(X0, X1, 12); F8_HQ2(X0, X1, 14); SBAR(); } while (0)
#define F8_REGION_B(X0, X1, N0, N1, DOMAX, kn) do { const v8i_t pb_ = (v8i_t){pw[0], pw[1], pw[2], pw[3], pw[4], pw[5], pw[6], pw[7]}; \
        ot0 = F8_MMA(vf0, pb_, ot0, 0x7F7F7F7F); F8_PIN(ot0); \
        kf00 = F8_LDK(kn, 0, 0); kf10 = F8_LDK(kn, 1, 0); \
        if (DOMAX) { mxa = fmaxf(fmaxf(N0[0], N0[1]), N1[0]); mxb = fmaxf(fmaxf(N0[2], N0[3]), N1[1]); mxa = fmaxf(fmaxf(mxa, N1[2]), N1[3]); \
            _Pragma("unroll") for (int r = 4; r < 8; r += 4) { mxa = fmaxf(fmaxf(mxa, N0[r]), N0[r + 1]); mxb = fmaxf(fmaxf(mxb, N0[r + 2]), N0[r + 3]); mxa = fmaxf(fmaxf(mxa, N1[r]), N1[r + 1]); mxb = fmaxf(fmaxf(mxb, N1[r + 2]), N1[r + 3]); } \
            asm volatile("" : "+v"(mxa), "+v"(mxb)); } \
        SBAR(); \
        ot1 = F8_MMA(vf1, pb_, ot1, 0x7F7F7F7F); F8_PIN(ot1); \
        kf01 = F8_LDK(kn, 0, 1); kf11 = F8_LDK(kn, 1, 1); \
        if (DOMAX) { \
            _Pragma("unroll") for (int r = 8; r < 16; r += 4) { mxa = fmaxf(fmaxf(mxa, N0[r]), N0[r + 1]); mxb = fmaxf(fmaxf(mxb, N0[r + 2]), N0[r + 3]); mxa = fmaxf(fmaxf(mxa, N1[r]), N1[r + 1]); mxb = fmaxf(fmaxf(mxb, N1[r + 2]), N1[r + 3]); } \
            asm volatile("" : "+v"(mxa), "+v"(mxb)); } \
        SBAR(); \
        lacc = __builtin_amdgcn_mfma_scale_f32_16x16x128_f8f6f4(ones8, pb_, lacc, 0, 0, 0, 0x7F7F7F7F, 0, 0x7F7F7F7F); F8_PIN(lacc); } while (0)
#define F8_RM_FINISH(rm) do { rm = fmaxf(mxa, mxb); auto rr_ = __builtin_amdgcn_permlane32_swap(__float_as_uint(rm), __float_as_uint(rm), false, false); rm = fmaxf(__uint_as_float(rr_[0]), __uint_as_float(rr_[1])); } while (0)
#define F8_ROT() do { const int t_ = s0; s0 = s1; s1 = s2; s2 = t_; } while (0)
#define F8_BODY(X0, X1, N0, N1, T) do { float mxa = 0.f, mxb = 0.f, rm_; v8i_t vf0, vf1; \
        F8_DMA(0, 0, s1, s2); \
        F8_REGION_A(X0, X1, N0, N1, s0 * VT); \
        F8_REGION_B(X0, X1, N0, N1, true, s2 * KT); \
        F8_RM_FINISH(rm_); \
        if (__any(rm_ > THR)) { const float dl_ = fmaxf(rm_ - BIAS, 0.f); m_ref += dl_; const float f_ = __builtin_amdgcn_exp2f(-dl_); \
            lacc[0] *= f_; lacc[1] *= __shfl(f_, (lane + 16) & 63);     \
            _Pragma("unroll") for (int r = 0; r < 16; ++r) { N0[r] -= dl_; N1[r] -= dl_; ot0[r] *= f_; ot1[r] *= f_; negm[r] = -m_ref; } } \
        F8_WAITBAR(NP); F8_ROT(); } while (0)
    int s0 = 0, s1 = 1, s2 = 2;
    v8i_t kf00, kf10, kf01, kf11;
    F8_DMA(0, 0, 0, 0); F8_DMA(1, 1, 1, 1); F8_DMA(2, 2, 2, 2);
    pa -= (aK ? 0 : 64); pb -= (bV ? 64 : (aK ? 0 : 64));
    F8_WAITBAR(2 * NP);
    {
        const v8i_t k00 = F8_LDK(0, 0, 0), k10 = F8_LDK(0, 1, 0), k01 = F8_LDK(0, 0, 1), k11 = F8_LDK(0, 1, 1);
        pA0 = F8_MMA(k00, q0, f32x16{}, SQ); pA1 = F8_MMA(k10, q0, f32x16{}, SQ); pA0 = F8_MMA(k01, q1, pA0, SQ); pA1 = F8_MMA(k11, q1, pA1, SQ);
        float mxa, mxb, rm;
        mxa = fmaxf(fmaxf(pA0[0], pA0[1]), pA1[0]); mxb = fmaxf(fmaxf(pA0[2], pA0[3]), pA1[1]); mxa = fmaxf(fmaxf(mxa, pA1[2]), pA1[3]);
#pragma unroll
        for (int r = 4; r < 16; r += 4) { mxa = fmaxf(fmaxf(mxa, pA0[r]), pA0[r + 1]); mxb = fmaxf(fmaxf(mxb, pA0[r + 2]), pA0[r + 3]); mxa = fmaxf(fmaxf(mxa, pA1[r]), pA1[r + 1]); mxb = fmaxf(fmaxf(mxb, pA1[r + 2]), pA1[r + 3]); }
        F8_RM_FINISH(rm);
        const float ref = rm - BIAS; m_ref = ref;
#pragma unroll
        for (int r = 0; r < 16; ++r) { pA0[r] -= ref; pA1[r] -= ref; negm[r] = -ref; }
    }
    F8_WAITBAR(NP);
    F8_DMA(0, 0, 0, 2);
    pa -= (aK ? 0 : 64); pb -= (bV ? 64 : (aK ? 0 : 64));
    kf00 = F8_LDK(KT, 0, 0); kf10 = F8_LDK(KT, 1, 0); kf01 = F8_LDK(KT, 0, 1); kf11 = F8_LDK(KT, 1, 1);
    F8_WAITBAR(NP);
    int t = 0;
    for (; t + 2 < NT; t += 2) { F8_BODY(pA0, pA1, pB0, pB1, t); F8_BODY(pB0, pB1, pA0, pA1, t + 1); }
    F8_BODY(pA0, pA1, pB0, pB1, t);
    {
        float mxa = 0.f, mxb = 0.f; (void)mxa; (void)mxb;
        const v8i_t vf0 = F8_LDV(s0 * VT, 0), vf1 = F8_LDV(s0 * VT, 1);
        F8_HQ(pB0, pB1, 0); F8_HQ(pB0, pB1, 1); F8_HQ(pB0, pB1, 2); F8_HQ(pB0, pB1, 3); F8_HQ(pB0, pB1, 4); F8_HQ(pB0, pB1, 5); F8_HQ(pB0, pB1, 6); F8_HQ(pB0, pB1, 7); F8_HQ(pB0, pB1, 8); F8_HQ(pB0, pB1, 9); F8_HQ(pB0, pB1, 10); F8_HQ(pB0, pB1, 11); F8_HQ(pB0, pB1, 12); F8_HQ(pB0, pB1, 13); F8_HQ(pB0, pB1, 14); F8_HQ(pB0, pB1, 15);
        F8_REGION_B(pB0, pB1, pA0, pA1, false, s2 * KT);
        F8_WAITBAR(0);
    }
#undef F8_DMA
#undef F8_WAITBAR
#undef F8_LDK
#undef F8_LDV
#undef F8_HQ
#undef F8_HQ2
#undef F8_REGION_A
#undef F8_PIN
#undef F8_REGION_B
#undef F8_RM_FINISH
#undef F8_ROT
#undef F8_BODY
    const float ls0_ = __shfl(lacc[0], lane & 15), ls1_ = __shfl(lacc[1], lane & 15);
    const float inv = __builtin_amdgcn_rcpf((lane & 16) ? ls1_ : ls0_);
    int lane2 = lane; asm volatile("" : "+v"(lane2));
    bf16_t* op = Ow + (size_t)(lane2 & 31) * ostride + 4 * (lane2 >> 5);
#pragma unroll
    for (int g = 0; g < 4; ++g) {
        *(u32x2*)(op + 8 * g) = (u32x2){pk2(ot0[4 * g] * inv, ot0[4 * g + 1] * inv), pk2(ot0[4 * g + 2] * inv, ot0[4 * g + 3] * inv)};
        *(u32x2*)(op + 32 + 8 * g) = (u32x2){pk2(ot1[4 * g] * inv, ot1[4 * g + 1] * inv), pk2(ot1[4 * g + 2] * inv, ot1[4 * g + 3] * inv)}; }
}

__device__ __forceinline__ void conv_load_u(const bf16_t* proj, int tile, int tid, u32x4 (&av)[6]) {
    const int t0 = tile * 64, s0 = t0 % SEQ;
#pragma unroll
    for (int q = 0; q < 6; ++q) { const int it = tid + q * 512; const int r = it >> 5, ch = (it & 31) * 8; const int sp = s0 - 15 + r;
        av[q] = (u32x4){0, 0, 0, 0};
        if (it < 94 * 32 && sp >= 0 && sp < SEQ) av[q] = *(const u32x4*)(proj + (size_t)(t0 - 15 + r) * NPROJ + PC_CFA + ch); }
}
__device__ __forceinline__ void conv_unit(const int tid, LAS unsigned char* lds, const bf16_t* proj, bf16_t* mixin, int tile,
                                          const float* sconv_w, const float* cconv_w, const float* cconv_b, const float* cnorm_g, const float* cnorm_b, u32x4 (&av)[6], int next_tile) {
    const int lane = tid & 63, wave = tid >> 6;
    const int t0 = tile * 64;
    const int s0 = t0 % SEQ;
    LAS bf16_t* ul = (LAS bf16_t*)lds;
    LAS float* vl = (LAS float*)(lds + 94 * 256 * 2);
    {
#pragma unroll
        for (int q = 0; q < 6; ++q) { const int it = tid + q * 512; const int r = it >> 5, ch = (it & 31) * 8;
            if (it < 94 * 32) *(LAS u32x4*)(ul + r * 256 + ch) = av[q]; }
        if (next_tile >= 0) conv_load_u(proj, next_tile, tid, av);
    }
#pragma unroll
    for (int qq = 0; qq < 2; ++qq) {
        u32x4 bbv[2], cv[2][3];
#pragma unroll
        for (int q = 0; q < 2; ++q) { const int it = tid + (qq * 2 + q) * 512; const int r = it >> 5, ch = (it & 31) * 8; const int sp = s0 + r;
            const bf16_t* pr = proj + (size_t)(t0 + r) * NPROJ;
            bbv[q] = *(const u32x4*)(pr + PC_SCB + ch);
#pragma unroll
            for (int k = 0; k < 3; ++k) { const int sq = sp + k - 1; cv[q][k] = (u32x4){0, 0, 0, 0};
                if (sq >= 0 && sq < SEQ) cv[q][k] = *(const u32x4*)(pr + (ptrdiff_t)(k - 1) * NPROJ + PC_SCC + ch); } }
#pragma unroll
        for (int q = 0; q < 2; ++q) { const int it = tid + (qq * 2 + q) * 512; const int r = it >> 5, ch = (it & 31) * 8;
            float acc8[8];
#pragma unroll
            for (int i = 0; i < 8; ++i) acc8[i] = 0.f;
#pragma unroll
            for (int k = 0; k < 3; ++k) { float cc[8]; unpack8(cv[q][k], cc);
                const f32x4 w0 = *(const f32x4*)(sconv_w + k * 256 + ch), w1 = *(const f32x4*)(sconv_w + k * 256 + ch + 4);
#pragma unroll
                for (int i = 0; i < 4; ++i) { acc8[i] += w0[i] * cc[i]; acc8[4 + i] += w1[i] * cc[4 + i]; } }
            float bf[8]; unpack8(bbv[q], bf);
#pragma unroll
            for (int i = 0; i < 8; ++i) acc8[i] *= bf[i];
            *(u32x4*)(mixin + (size_t)(t0 + r) * DM + 256 + ch) = pack8(acc8); }
    }
    __syncthreads();
    {
        const int c = tid & 255, half = tid >> 8;
        float w[31];
#pragma unroll
        for (int k = 0; k < 31; ++k) w[k] = cconv_w[k * 256 + c];
        const float bias = cconv_b[c];
        float uu[62];
#pragma unroll
        for (int i = 0; i < 62; ++i) uu[i] = bf2f(ul[(half * 32 + i) * 256 + c]);
#pragma unroll
        for (int tt = 0; tt < 32; ++tt) {
            float a0 = bias, a1 = 0.f;
#pragma unroll
            for (int k = 0; k < 30; k += 2) { a0 += w[k] * uu[tt + k]; a1 += w[k + 1] * uu[tt + k + 1]; }
            a0 += w[30] * uu[tt + 30];
            vl[(half * 32 + tt) * 256 + c] = a0 + a1;
        }
    }
    __syncthreads();
    {
        const f32x4 gg = *(const f32x4*)(cnorm_g + lane * 4), bb = *(const f32x4*)(cnorm_b + lane * 4);
#pragma unroll
        for (int tt = 0; tt < 8; ++tt) {
            const int t = wave * 8 + tt;
            f32x4 v = *(const LAS f32x4*)(vl + t * 256 + lane * 4);
            const float mean = wave_sum(v[0] + v[1] + v[2] + v[3]) * (1.0f / 256.0f);
            v = v - mean;
            const float var = wave_sum(v[0] * v[0] + v[1] * v[1] + v[2] * v[2] + v[3] * v[3]) * (1.0f / 256.0f);
            const float rstd = __builtin_amdgcn_rsqf(var + LN_EPS);
            f32x4 y = v * rstd * gg + bb;
#pragma unroll
            for (int j = 0; j < 4; ++j) y[j] = y[j] * fast_sigmoid(y[j]);
            *(u32x2*)(mixin + (size_t)(t0 + t) * DM + 512 + lane * 4) = (u32x2){pk2(y[0], y[1]), pk2(y[2], y[3])};
        }
    }
    __syncthreads();
}

enum { SRC_IN = 0, SRC_UQ, SRC_UKV, SRC_PLAIN };
__device__ __forceinline__ int src_col_in(int n) {
    const int tile = n >> 8, p = n & 255;
    switch (tile) {
        case 0: return SC_QLAT + p;
        case 1: return p < 128 ? SC_KVLAT + p : (p < 160 ? SC_KROPE + (p - 128) : -1);
        case 2: return SC_SCB + p;
        case 3: return p < 128 ? SC_SCC + p : SC_SCH + (p - 128); case 4: return p < 128 ? SC_SCC + 128 + p : SC_SCH + 128 + (p - 128);
        case 5: return p < 128 ? SC_CFA + p : SC_CFG + (p - 128); case 6: return p < 128 ? SC_CFA + 128 + p : SC_CFG + 128 + (p - 128);
        case 7: { const int hh = p >> 6, pp = p & 63, w = pp >> 5, nn = (pp >> 4) & 1, j = pp & 15; return SC_GQQ + hh * 64 + 16 * w + j + 32 * nn; }
        default: { if (p < 128) { const int hh = p >> 6, pp = p & 63, w = pp >> 5, nn = (pp >> 4) & 1, j = pp & 15; return SC_GQK + hh * 64 + 16 * w + j + 32 * nn; } return SC_GQV + (p - 128); }
    }
}
__device__ __forceinline__ void transpose_item(const float* W0, const float* W1, int kind, int K, int Nsrc, int Nvalid, bf16_t* WT, const float* kscale, float mult,
                                               LAS float* scr, int item, int nblk, int lane) {
    const int kb = item / nblk, nb = item % nblk, k0 = 64 * kb, n0 = 32 * nb;
    const int n = n0 + (lane & 31);
    const float* src = nullptr;
    if (kind == SRC_IN) { const int tl = n >> 8; const bool pm_ = (tl == 0) || (tl >= 2 && tl <= 6) || (tl == 1 && (n & 255) < 128);
        const int sc = src_col_in(pm_ ? ((n & ~31) + perm32(n & 31)) : n); if (sc >= 0) src = W0 + sc; }
    else if (kind == SRC_UQ || kind == SRC_UKV) { if (n < Nvalid) src = W0 + n; }
    else if (kind == SRC_PLAIN) { src = W0 + (n & ~31) + perm32(n & 31); }
    else { const int j = n >> 8, r = n & 255; src = (r < 128) ? W0 + 128 * j + r : W1 + 128 * j + (r - 128); }
#pragma unroll 8
    for (int i = 0; i < 32; ++i) { const int kk = 2 * i + (lane >> 5); float v = 0.f; if (src) v = src[(size_t)(k0 + kk) * Nsrc]; if (kscale) v *= kscale[k0 + kk] * mult; scr[kk * 33 + (lane & 31)] = v; }
    asm volatile("s_waitcnt lgkmcnt(0)" ::: "memory");
    const int c = lane & 7;
#pragma unroll
    for (int j = 0; j < 4; ++j) { const int nn = (lane >> 3) + 8 * j; const LAS float* s = scr + (8 * c) * 33 + nn;
        u32x4 o; o.x = pk2(s[0 * 33], s[1 * 33]); o.y = pk2(s[2 * 33], s[3 * 33]); o.z = pk2(s[4 * 33], s[5 * 33]); o.w = pk2(s[6 * 33], s[7 * 33]);
        *(u32x4*)(WT + (size_t)(n0 + nn) * K + k0 + 8 * c) = o; }
    asm volatile("s_waitcnt lgkmcnt(0)" ::: "memory");
}
constexpr int SRC_GU = 9;

__device__ __forceinline__ void transpose64(const float* Wsrc, int Nsrc, bf16_t* WTdst, int K, LAS float* scr, int lane) {
    f32x4 v[16];
#pragma unroll
    for (int i = 0; i < 16; ++i) v[i] = __builtin_nontemporal_load((const f32x4*)(Wsrc + (size_t)(4 * i + (lane >> 4)) * Nsrc + (lane & 15) * 4));
#pragma unroll
    for (int i = 0; i < 16; ++i) { LAS float* d = scr + (4 * i + (lane >> 4)) * 65 + (lane & 15) * 4; d[0] = v[i][0]; d[1] = v[i][1]; d[2] = v[i][2]; d[3] = v[i][3]; }
    asm volatile("s_waitcnt lgkmcnt(0)" ::: "memory");
    const int c = lane & 7;
#pragma unroll
    for (int j = 0; j < 8; ++j) { const int nn = (lane >> 3) + 8 * j; const LAS float* s = scr + (8 * c) * 65 + (nn & 32) + perm32(nn & 31);
        u32x4 o; o.x = pk2(s[0 * 65], s[1 * 65]); o.y = pk2(s[2 * 65], s[3 * 65]); o.z = pk2(s[4 * 65], s[5 * 65]); o.w = pk2(s[6 * 65], s[7 * 65]);
        *(u32x4*)(WTdst + (size_t)nn * K + 8 * c) = o; }
    asm volatile("s_waitcnt lgkmcnt(0)" ::: "memory");
}


__device__ __forceinline__ void transpose64_fp8(const float* Wsrc, int Nsrc, unsigned char* WTdst, int Kb, float sc, LAS float* scr, int lane) {
    f32x4 v[16];
#pragma unroll
    for (int i = 0; i < 16; ++i) v[i] = __builtin_nontemporal_load((const f32x4*)(Wsrc + (size_t)(4 * i + (lane >> 4)) * Nsrc + (lane & 15) * 4));
#pragma unroll
    for (int i = 0; i < 16; ++i) { LAS float* d = scr + (4 * i + (lane >> 4)) * 65 + (lane & 15) * 4; d[0] = v[i][0]; d[1] = v[i][1]; d[2] = v[i][2]; d[3] = v[i][3]; }
    asm volatile("s_waitcnt lgkmcnt(0)" ::: "memory");
    const int c = lane & 7;
#pragma unroll
    for (int j = 0; j < 8; ++j) { const int nn = (lane >> 3) + 8 * j; const LAS float* s = scr + (8 * c) * 65 + (nn & 32) + perm32(nn & 31);
        int w0 = __builtin_amdgcn_cvt_pk_fp8_f32(s[0 * 65] * sc, s[1 * 65] * sc, 0, false); w0 = __builtin_amdgcn_cvt_pk_fp8_f32(s[2 * 65] * sc, s[3 * 65] * sc, w0, true);
        int w1 = __builtin_amdgcn_cvt_pk_fp8_f32(s[4 * 65] * sc, s[5 * 65] * sc, 0, false); w1 = __builtin_amdgcn_cvt_pk_fp8_f32(s[6 * 65] * sc, s[7 * 65] * sc, w1, true);
        *(u32x2*)(WTdst + (size_t)nn * Kb + 8 * c) = (u32x2){(unsigned)w0, (unsigned)w1}; }
    asm volatile("s_waitcnt lgkmcnt(0)" ::: "memory");
}

#define XB_TMO      128
#define XB_XCNT(j)  (256  + 64 * (j))
#define XB_XSUB(j)  (1280 + 64 * (j))
#define XB_XGEN(j)  (2304 + 64 * (j))
#define XB_TOP      3328
#define XB_TOPGEN   3392
#define XB_SPIN_CAP (1u << 22)
__device__ __forceinline__ unsigned xb_ld(unsigned* p)              { return __hip_atomic_load(p, __ATOMIC_RELAXED, __HIP_MEMORY_SCOPE_AGENT); }
__device__ __forceinline__ unsigned xb_add(unsigned* p, unsigned v) { return __hip_atomic_fetch_add(p, v, __ATOMIC_RELAXED, __HIP_MEMORY_SCOPE_AGENT); }
__device__ __forceinline__ unsigned xb_xcc_id() { return (unsigned)__builtin_amdgcn_s_getreg((3 << 11) | 20) & 0xFu; }
#define XB_SPIN(cond, bar) do { unsigned _sp = 0; while (cond) { __builtin_amdgcn_s_sleep(1); \
    if ((++_sp & 255u) == 0u) { if (xb_ld(&(bar)[XB_TMO])) break; if (_sp > XB_SPIN_CAP) { atomicAdd(&(bar)[XB_TMO], 1u); break; } } } } while (0)
__device__ __forceinline__ void xcd_barrier_complete(unsigned* bar, unsigned x, unsigned& nloc, unsigned& nx) {
    const unsigned G = gridDim.x * gridDim.y * gridDim.z;
    unsigned sum, cnt, mine, sp = 0u;
    for (;;) {
        sum = 0u; cnt = 0u; mine = 0u;
#pragma unroll
        for (unsigned j = 0; j < 16; ++j) { const unsigned c = xb_ld(&bar[XB_XCNT(j)]); sum += c; cnt += (c > 0u) ? 1u : 0u; mine = (j == x) ? c : mine; }
        if (sum == G) break;
        __builtin_amdgcn_s_sleep(1);
        if ((++sp & 255u) == 0u) { if (xb_ld(&bar[XB_TMO])) break; if (sp > XB_SPIN_CAP) { atomicAdd(&bar[XB_TMO], 1u); break; } }
    }
    nloc = mine > 0u ? mine : 1u; nx = cnt > 0u ? cnt : 1u;
}
__device__ __forceinline__ unsigned xcd_arrive(unsigned* bar, volatile LAS unsigned* st) {
    __builtin_amdgcn_s_waitcnt(0);
    const unsigned x = xb_xcc_id();
    unsigned nloc = st[0], nx = st[1];
    if (nloc == 0u) { xcd_barrier_complete(bar, x, nloc, nx); st[0] = nloc; st[1] = nx; }
    const unsigned old = xb_add(&bar[XB_XSUB(x)], 1u);
    const unsigned gen = old / nloc;
    if (old + 1u == (gen + 1u) * nloc) {
        __builtin_amdgcn_fence(__ATOMIC_RELEASE, "agent");
        asm volatile("s_waitcnt vmcnt(0)" ::: "memory");
        (void)xb_add(&bar[XB_TOP], 1u);
    }
    return (gen + 1u) * nx;
}
__device__ __forceinline__ void xcd_wait(unsigned* bar, unsigned target) {
    XB_SPIN(xb_ld(&bar[XB_TOP]) < target, bar);
    __builtin_amdgcn_fence(__ATOMIC_ACQUIRE, "agent");
    asm volatile("s_waitcnt vmcnt(0)" ::: "memory");
}
__device__ __forceinline__ void xcd_barrier(unsigned* bar, volatile LAS unsigned* st) {
    asm volatile("" : "+s"(bar));
    asm volatile("s_waitcnt vmcnt(0)" ::: "memory");
    __syncthreads();
    if (threadIdx.x == 0) { const unsigned tg = xcd_arrive(bar, st); xcd_wait(bar, tg); }
    __syncthreads();
}

struct Args { const void* in[23]; float* out; unsigned char* ws; int ph_lo, ph_hi; };
constexpr int NPH = 10;

__global__ void __launch_bounds__(512, 2) fwd_kernel(Args args) {
    extern __shared__ __attribute__((aligned(16))) unsigned char lds_raw[];
    typedef const __attribute__((address_space(4))) unsigned char* kaptr_t;
#define PH_PROLOG \
    kaptr_t ka = (kaptr_t)__builtin_amdgcn_kernarg_segment_ptr(); asm volatile("" : "+s"(ka)); \
    unsigned char* ws = ((unsigned char* const __attribute__((address_space(4)))*)ka)[24]; float* xres = ((float* const __attribute__((address_space(4)))*)ka)[23]; (void)xres; (void)ws; \
    int G = gridDim.x, bx = blockIdx.x; asm volatile("" : "+s"(G), "+s"(bx)); const int vcu = (G % 8 == 0) ? (bx % 8) * (G / 8) + bx / 8 : bx; const int NGW = G * 8; (void)NGW; \
    int tid = threadIdx.x; asm volatile("" : "+v"(tid)); const int lane = tid & 63, wave = __builtin_amdgcn_readfirstlane(tid >> 6); const int gw = vcu * 8 + wave; (void)lane; (void)gw;
#define INF(i) ((const float*)(((const void* const __attribute__((address_space(4)))*)ka)[i]))
#define WSP(T, off) ((T*)(ws + (off)))
    volatile LAS unsigned* xb_st = (volatile LAS unsigned*)((LAS unsigned char*)lds_raw + GIDX_OFF + GIDX_BYTES);
    if (threadIdx.x < 2) xb_st[threadIdx.x] = 0u;
    if (threadIdx.x == 0) (void)xb_add((unsigned*)args.ws + 4096 + XB_XCNT(xb_xcc_id()), 1u);
    __syncthreads();
#define GRID_SYNC() xcd_barrier((unsigned*)args.ws + 4096, xb_st)
    const int lo = args.ph_lo, hi = args.ph_hi;
    LAS unsigned char* lds = (LAS unsigned char*)lds_raw;
#ifndef PHMASK
#define PHMASK 0x3ff
#endif
#define IN_PH(k) (((PHMASK >> ((k) % NPH)) & 1) && lo <= (k) && (k) < hi)
#ifndef PROBE_PH
#define PROBE_PH -1
#endif
#ifndef PROBE_N
#define PROBE_N 1
#endif
#define REPS(k) for (int rep_ = 0; rep_ < ((PROBE_PH == (k)) ? 1 + PROBE_N : 1); ++rep_)
#ifndef PROBE_SUB
#define PROBE_SUB -1
#endif
#define SUBREPS(i) for (int r2_ = 0; r2_ < ((PROBE_SUB == (i)) ? 2 : 1); ++r2_)
#define SEAM(k) do { if (IN_PH(k) && IN_PH((k) + 1)) GRID_SYNC(); } while (0)
#define SEAM_WORK(k, WORK) do { if (IN_PH(k) && IN_PH((k) + 1)) { \
        unsigned* bar_ = (unsigned*)args.ws + 4096; asm volatile("" : "+s"(bar_)); \
        asm volatile("s_waitcnt vmcnt(0)" ::: "memory"); __syncthreads(); \
        if (threadIdx.x == 0) xb_st[2] = xcd_arrive(bar_, xb_st); \
        { WORK } \
        asm volatile("" : "+s"(bar_)); \
        if (threadIdx.x == 0) xcd_wait(bar_, xb_st[2]); \
        __syncthreads(); } } while (0)
#define SEAM_GU(k, q) SEAM_GUX(k, q, )
#define SEAM_GUX(k, q, EXTRA) do { if (IN_PH(k) && IN_PH((k) + 1)) { \
        unsigned* bar_ = (unsigned*)args.ws + 4096; asm volatile("" : "+s"(bar_)); \
        asm volatile("s_waitcnt vmcnt(0)" ::: "memory"); __syncthreads(); \
        if (threadIdx.x == 0) xb_st[2] = xcd_arrive(bar_, xb_st); \
        { PH_PROLOG \
          LAS float* scr = (LAS float*)(lds + wave * 16640); \
          const int it = (q) * NGW + gw, e = it >> 9, r = it & 511, kb = r >> 5, nb = r & 31, n0 = nb * 64, j = n0 >> 8, rr = n0 & 255; \
          if (it < NE * 512) { const size_t wo = ((size_t)l * NE + e) * DM * FF; \
            const float* src = (rr < 128 ? INF(18) + wo + 128 * j + rr : INF(19) + wo + 128 * j + (rr - 128)) + (size_t)kb * 64 * FF; \
            transpose64_fp8(src, FF, WSP(unsigned char, WS_WGU) + ((size_t)e * 2048 + n0) * DM + kb * 64, DM, rr < 128 ? 32.0f * LOG2E : 32.0f / LOG2E, scr, lane); } \
          EXTRA } \
        asm volatile("" : "+s"(bar_)); \
        if (threadIdx.x == 0) xcd_wait(bar_, xb_st[2]); \
        __syncthreads(); } } while (0)

#define CONVERT_SMALL(lw, scr_off) do { LAS float* scr = (LAS float*)(lds + (scr_off) + wave * 8448); \
            constexpr int I_IN = 16 * 72, I_UQ = 4 * 16, I_UKV = 2 * 16, I_OUT = 16 * 32; \
            for (int it = gw; it < I_IN + I_UQ + I_UKV + I_OUT; it += NGW) { \
                int r = it; \
                if (r < I_IN) { transpose_item(INF(2) + (size_t)(lw) * DM * DIN, nullptr, SRC_IN, DM, DIN, 0, WSP(bf16_t, WS_WIN), nullptr, 1.f, scr, r, 72, lane); continue; } r -= I_IN; \
                if (r < I_UQ) { transpose_item(INF(4) + (size_t)(lw) * 256 * 384, nullptr, SRC_UQ, 256, 384, 384, WSP(bf16_t, WS_WUQ), INF(3) + (lw) * 256, 0.10206207261596575f * LOG2E, scr, r, 16, lane); continue; } r -= I_UQ; \
                if (r < I_UKV) { transpose_item(INF(6) + (size_t)(lw) * 128 * 512, nullptr, SRC_UKV, 128, 512, 512, WSP(bf16_t, WS_WUKV), INF(5) + (lw) * 128, 1.f, scr, r, 16, lane); continue; } r -= I_UKV; \
                transpose_item(INF(13) + (size_t)(lw) * DM * DM, nullptr, SRC_PLAIN, DM, DM, DM, WSP(bf16_t, WS_WOUT), nullptr, 1.f, scr, r, 32, lane); \
            } } while (0)
    {
        if (IN_PH(0)) REPS(0) {
            PH_PROLOG
            CONVERT_SMALL(0, 0);
            {
                const int* positions = (const int*)INF(1);
                float* cosA = WSP(float, WS_COSA); float* sinA = WSP(float, WS_SINA); float* cosD = WSP(float, WS_COSD); float* sinD = WSP(float, WS_SIND);
                LAS float* inv_l = (LAS float*)(lds + 8 * 8448);
                if (tid < 48) inv_l[tid] = (tid < 16) ? 1.0f / powf(10000.0f, (float)(2 * tid) / 32.0f) : 1.0f / powf(10000.0f, (float)(2 * (tid - 16)) / 64.0f);
                __syncthreads();
                for (int i = bx * 512 + tid; i < NTOK * 48; i += G * 512) {
                    const int t = i / 48, j = i % 48; const float a = (float)positions[t] * inv_l[j];
                    double rv_ = (double)a * 0.15915494309189535; rv_ -= __builtin_rint(rv_);
                    const float rf_ = (float)rv_, sn = __builtin_amdgcn_sinf(rf_), cs = __builtin_amdgcn_cosf(rf_);
                    if (j < 16) { cosA[t * 16 + j] = cs; sinA[t * 16 + j] = sn; } else { cosD[t * 32 + j - 16] = cs; sinD[t * 32 + j - 16] = sn; }
                }
                const float* x_in = INF(0); bf16_t* xbf = WSP(bf16_t, WS_XBF);
                for (int m = gw; m < NTOK; m += 4 * NGW) {
                    f32x4 v[4][4];
#pragma unroll
                    for (int r = 0; r < 4; ++r)
#pragma unroll
                        for (int j = 0; j < 4; ++j) v[r][j] = __builtin_nontemporal_load((const f32x4*)(x_in + (size_t)(m + r * NGW) * DM) + lane + 64 * j);
#pragma unroll
                    for (int r = 0; r < 4; ++r)
#pragma unroll
                        for (int j = 0; j < 4; ++j) ((u32x2*)(xbf + (size_t)(m + r * NGW) * DM) + lane)[64 * j] = (u32x2){pk2(v[r][j][0], v[r][j][1]), pk2(v[r][j][2], v[r][j][3])};
                }
            }
        }
        SEAM(0);
    }
    for (int l = 0; l < DEPTH; ++l) {
        const int P = l * NPH;
        if (IN_PH(P + 1)) REPS(1) {
            PH_PROLOG
            pg8::Gemm g{WSP(bf16_t, WS_XBF), WSP(bf16_t, WS_WIN), DM, DM, DM, 0, 0}; pg8::OrderT<NPROJ / 256> S; S.init(G, bx);
            EpiProj E{WSP(bf16_t, WS_R1), WSP(float, WS_SSQQ), WSP(float, WS_SSQKV), WSP(unsigned char, WS_KM), WSP(bf16_t, WS_VTG), WSP(float, WS_COSA), WSP(float, WS_SINA), WSP(float, WS_COSD), WSP(float, WS_SIND)};
            pg8::gemm_phase<EpiProj, false, pg8::OrderT<NPROJ / 256>>(tid, lds, nullptr, g, S, E);
            {
                const int nwg = (NTOK / 256) * (NPROJ / 256), nfull = nwg % G;
                if (nfull != 0 && bx >= nfull) {
                    LAS float* scr = (LAS float*)(lds + wave * 16640);
                    const float* w_down = INF(20);
                    const int nidle = G - nfull;
                    for (int it = (bx - nfull) * 8 + wave; it < NE * 256; it += nidle * 8) {
                        const int e = it >> 8, r = it & 255, kb = r >> 4, nb = r & 15;
                        const size_t wo = ((size_t)l * NE + e) * DM * FF;
                        transpose64_fp8(w_down + wo + (size_t)kb * 64 * DM + nb * 64, DM, WSP(unsigned char, WS_WD) + ((size_t)e * DM + nb * 64) * FF + kb * 64, FF, 64.0f, scr, lane);
                    }
                }
            }
        }
        SEAM_GU(P + 1, 0);
        if (IN_PH(P + 2)) REPS(2) {
            { PH_PROLOG
              pg8::Gemm g{WSP(bf16_t, WS_R1) + PC_QLAT, WSP(bf16_t, WS_WUQ), NPROJ, 256, 256, 0, 0}; pg8::OrderT<2> S; S.init(G, bx);
              EpiQup E{WSP(unsigned char, WS_QM), WSP(float, WS_SSQQ), WSP(float, WS_COSA), WSP(float, WS_SINA)}; pg8::gemm_phase<EpiQup, false, pg8::OrderT<2>>(tid, lds, nullptr, g, S, E); }
            { PH_PROLOG
              pg8::Gemm g{WSP(bf16_t, WS_R1) + PC_KVLAT, WSP(bf16_t, WS_WUKV), NPROJ, 128, 128, 0, 0}; pg8::OrderT<2> S; S.init(G, bx);
              EpiKVup E{WSP(unsigned char, WS_KM), WSP(unsigned char, WS_VTM), WSP(float, WS_SSQKV)}; pg8::gemm_phase<EpiKVup, false, pg8::OrderT<2>>(tid, lds, nullptr, g, S, E); }
        }
        SEAM_GU(P + 2, 1);
        if (IN_PH(P + 3)) REPS(3) {
            SUBREPS(0) { PH_PROLOG
              const int per = (512 + G - 1) / G;
              bf16_t* mixin = WSP(bf16_t, WS_MIXIN);
              for (int u = vcu * per; u < (vcu + 1) * per && u < 512; ++u) {
                const int bh = u >> 4, qb = u & 15, b = bh >> 2, h = bh & 3;
                const unsigned char* Qw = WSP(unsigned char, WS_QM) + ((size_t)bh * SEQ + qb * 256 + wave * 32) * 96;
                bf16_t* Ow = mixin + ((size_t)b * SEQ + qb * 256 + wave * 32) * DM + h * 64;
                attn_mla_f8(tid, lds, Qw, WSP(unsigned char, WS_KM) + (size_t)bh * SEQ * 96, WSP(unsigned char, WS_VTM) + (size_t)bh * 64 * SEQ, Ow, DM);
              } }
            SUBREPS(1) { PH_PROLOG
              const int per = (512 + G - 1) / G;
              bf16_t* mixin = WSP(bf16_t, WS_MIXIN); const bf16_t* proj = WSP(bf16_t, WS_R1); const float* sink = INF(12);
              for (int u = vcu * per; u < (vcu + 1) * per && u < 512; ++u) {
                const int bk = u >> 5, nb = u & 31, b = bk >> 1, kvh = bk & 1;
                const int gi = wave >> 2, qoff = nb * 128 + (wave & 3) * 32, hq = kvh * 2 + gi;
                const bf16_t* Qw = proj + ((size_t)b * SEQ + qoff) * NPROJ + PC_GQQ + hq * 64;
                const bf16_t* Kb = proj + (size_t)b * SEQ * NPROJ + PC_GQK + kvh * 64;
                bf16_t* Ow = mixin + ((size_t)b * SEQ + qoff) * DM + 768 + hq * 64;
                const int t_lo = (2 * nb - 2) < 0 ? 0 : (2 * nb - 2), t_hi = (2 * nb + 4) > 64 ? 64 : (2 * nb + 4);
                attn_unit<64, true>(tid, lds, Qw, NPROJ, Kb, NPROJ, WSP(bf16_t, WS_VTG) + (size_t)bk * 64 * SEQ, Ow, DM, qoff, t_lo, t_hi, sink[l * 4 + hq] * LOG2E);
              } }
            SUBREPS(2) { PH_PROLOG
              const int per = (512 + G - 1) / G;
              u32x4 av[6]; conv_load_u(WSP(bf16_t, WS_R1), vcu * per, tid, av);
              for (int u = vcu * per; u < (vcu + 1) * per && u < 512; ++u)
                conv_unit(tid, lds, WSP(bf16_t, WS_R1), WSP(bf16_t, WS_MIXIN), u, INF(7) + l * 3 * 256, INF(8) + l * 31 * 256, INF(9) + l * 256, INF(10) + l * 256, INF(11) + l * 256, av, (u + 1 < (vcu + 1) * per && u + 1 < 512) ? u + 1 : -1);
            }
        }
        SEAM_GU(P + 3, 2);
        if (IN_PH(P + 4)) REPS(4) {
            PH_PROLOG
            pg8::Gemm g{WSP(bf16_t, WS_MIXIN), WSP(bf16_t, WS_WOUT), DM, DM, DM, 0, 0}; pg8::OrderT<4> S; S.init(G, bx);
            EpiOut E{WSP(bf16_t, WS_XBF)};
            pg8::gemm_phase<EpiOut, false, pg8::OrderT<4>>(tid, lds, nullptr, g, S, E);
        }
        SEAM_GUX(P + 4, 3, { __syncthreads();
            LAS bf16_t* wr_l = (LAS bf16_t*)lds; LAS float* g_l = (LAS float*)(lds + 32768); LAS float* b_l = (LAS float*)(lds + 32768 + 4096); const float* w_router = INF(16);
            for (int i = tid; i < DM * NE; i += 512) { const int d = i >> 4; const int e2 = i & 15; wr_l[(((d >> 5) * 4 + ((d >> 3) & 3)) * 16 + e2) * 8 + (d & 7)] = f2bf(w_router[(size_t)l * DM * NE + i]); }
            for (int i = tid; i < DM; i += 512) { g_l[i] = INF(14)[l * DM + i]; b_l[i] = INF(15)[l * DM + i]; } });
        if (IN_PH(P + 5)) REPS(5) {
            { PH_PROLOG
            LAS bf16_t* wr_l = (LAS bf16_t*)lds;
            LAS float* g_l = (LAS float*)(lds + 32768);
            LAS float* b_l = (LAS float*)(lds + 32768 + 4096);
            const float* b_router = INF(17);
            const int tk = lane & 15, g4 = lane >> 4;
            const float brt = b_router[l * NE + tk];
            bf16_t* xbf = WSP(bf16_t, WS_XBF); float* aff_t = WSP(float, WS_AFF); unsigned char* xf8 = WSP(unsigned char, WS_XF8);
            for (int m0 = gw * 16; m0 < NTOK; m0 += NGW * 16) {
                bf16_t* xrow = xbf + (size_t)(m0 + tk) * DM + g4 * 8;
                u32x4 xp[32];
#pragma unroll
                for (int s_ = 0; s_ < 32; ++s_) xp[s_] = *(const u32x4*)(xrow + 32 * s_);
                float s1 = 0.f, s2 = 0.f;
#pragma unroll
                for (int s_ = 0; s_ < 32; ++s_) { float v[8]; unpack8(xp[s_], v);
#pragma unroll
                    for (int j = 0; j < 8; ++j) { s1 += v[j]; s2 += v[j] * v[j]; } asm volatile("" : "+v"(s1), "+v"(s2)); }
                s1 += __shfl_xor(s1, 16); s1 += __shfl_xor(s1, 32); s2 += __shfl_xor(s2, 16); s2 += __shfl_xor(s2, 32);
                const float mean = s1 * (1.0f / DM); const float var = fmaxf(s2 * (1.0f / DM) - mean * mean, 0.f);
                const float rstd = __builtin_amdgcn_rsqf(var + LN_EPS);
                f32x4 lg = {0.f, 0.f, 0.f, 0.f};
#pragma unroll
                for (int s_ = 0; s_ < 32; ++s_) {
                    asm volatile("" : "+v"(xp[s_]));
                    float v[8]; unpack8(xp[s_], v);
                    const f32x4 ga = *(const LAS f32x4*)(g_l + 32 * s_ + 8 * g4), gb = *(const LAS f32x4*)(g_l + 32 * s_ + 8 * g4 + 4);
                    const f32x4 ba = *(const LAS f32x4*)(b_l + 32 * s_ + 8 * g4), bb_ = *(const LAS f32x4*)(b_l + 32 * s_ + 8 * g4 + 4);
#pragma unroll
                    for (int j = 0; j < 4; ++j) { v[j] = (v[j] - mean) * rstd * ga[j] + ba[j]; v[4 + j] = (v[4 + j] - mean) * rstd * gb[j] + bb_[j]; }
                    const u32x4 o = pack8(v);
                    *(u32x4*)(xrow + 32 * s_) = o;
                    { int w0 = __builtin_amdgcn_cvt_pk_fp8_f32(v[0], v[1], 0, false); w0 = __builtin_amdgcn_cvt_pk_fp8_f32(v[2], v[3], w0, true);
                      int w1 = __builtin_amdgcn_cvt_pk_fp8_f32(v[4], v[5], 0, false); w1 = __builtin_amdgcn_cvt_pk_fp8_f32(v[6], v[7], w1, true);
                      *(u32x2*)(xf8 + (size_t)(m0 + tk) * DM + 32 * s_ + 8 * g4) = (u32x2){(unsigned)w0, (unsigned)w1}; }
                    const bf16x8 wf = *(const LAS bf16x8*)(wr_l + ((s_ * 4 + g4) * 16 + tk) * 8);
                    lg = __builtin_amdgcn_mfma_f32_16x16x32_bf16(__builtin_bit_cast(bf16x8, o), wf, lg, 0, 0, 0);
                    asm volatile("" ::: "memory");
                }
                f32x4 av;
#pragma unroll
                for (int r = 0; r < 4; ++r) {
                    const float lgt = lg[r] + brt; const float mx = row16_max(lgt);
                    const float ev = __expf(lgt - mx); const float den = row16_sum(ev);
                    av[r] = ev * __builtin_amdgcn_rcpf(den);
                }
                { const int mt = m0 + 4 * g4, b = mt / SEQ, sq = mt % SEQ; *(f32x4*)(aff_t + ((size_t)b * NE + tk) * SEQ + sq) = av; }
            }
            __syncthreads();
            }
        }
        SEAM_WORK(P + 5, if (l + 1 < DEPTH) { PH_PROLOG CONVERT_SMALL(l + 1, 0); });
        if (IN_PH(P + 7)) REPS(7) {
            PH_PROLOG
            pg8::PanelOrder S; S.init(bx, 8);
            LAS int* gidx = (LAS int*)(lds + GIDX_OFF);
            LAS float* gate_l = (LAS float*)(lds + GIDX_OFF + 1024);
            {
                LAS unsigned* hist = (LAS unsigned*)lds;
                LAS unsigned* wtot = (LAS unsigned*)(lds + 4096);
                const float* aff_t = WSP(float, WS_AFF); int* slot_of = WSP(int, WS_SLOT);
                const int e = S.e, b = S.pm >> 1, half = S.pm & 1, p = b * NE + e;
                unsigned key[8];
                { const u32x4 a0 = *((const u32x4*)(aff_t + (size_t)p * SEQ) + 2 * tid), a1 = *((const u32x4*)(aff_t + (size_t)p * SEQ) + 2 * tid + 1);
                  key[0] = a0[0]; key[1] = a0[1]; key[2] = a0[2]; key[3] = a0[3]; key[4] = a1[0]; key[5] = a1[1]; key[6] = a1[2]; key[7] = a1[3]; }
                for (int i = tid; i < 1024; i += 512) hist[i] = 0u;
                __syncthreads();
                unsigned prefix = 0u, pmask = 0u, kneed = CAP;
#pragma unroll
                for (int pass = 0; pass < 4; ++pass) {
                    const int shift = 24 - 8 * pass;
                    LAS unsigned* h = hist + pass * 256;
#pragma unroll
                    for (int j = 0; j < 8; ++j) if ((key[j] & pmask) == prefix) atomicAdd((unsigned*)(h + ((key[j] >> shift) & 255u)), 1u);
                    __syncthreads();
                    const u32x4 c = *((const LAS u32x4*)h + lane);
                    const unsigned own = c[0] + c[1] + c[2] + c[3];
                    unsigned suf = own;
#pragma unroll
                    for (int o = 1; o < 64; o <<= 1) { const unsigned t = __shfl_down(suf, o); if (lane + o < 64) suf += t; }
                    unsigned above = suf - own;
                    int found = -1; unsigned knew = 0u;
#pragma unroll
                    for (int q = 3; q >= 0; --q) { if (found < 0 && above < kneed && above + c[q] >= kneed) { found = 4 * lane + q; knew = kneed - above; } above += c[q]; }
                    const unsigned long long bm = __ballot(found >= 0);
                    const int src = __builtin_ctzll(bm);
                    const unsigned d = (unsigned)__builtin_amdgcn_readlane(found, src); kneed = (unsigned)__builtin_amdgcn_readlane((int)knew, src);
                    prefix |= d << shift; pmask |= 255u << shift;
                }
                unsigned ngt = 0u, neq = 0u;
#pragma unroll
                for (int j = 0; j < 8; ++j) { ngt += (key[j] > prefix) ? 1u : 0u; neq += (key[j] == prefix) ? 1u : 0u; }
                unsigned packed = ngt | (neq << 16), inc = packed;
#pragma unroll
                for (int o = 1; o < 64; o <<= 1) { const unsigned t = __shfl_up(inc, o); if (lane >= o) inc += t; }
                if (lane == 63) wtot[wave] = inc;
                __syncthreads();
                unsigned base = 0u;
                for (int w = 0; w < wave; ++w) base += wtot[w];
                unsigned excl = base + inc - packed;
                unsigned rgt = excl & 0xffffu, req = excl >> 16;
                const unsigned cnt_gt = CAP - kneed;
                int so[8];
#pragma unroll
                for (int j = 0; j < 8; ++j) {
                    int slot = -1;
                    if (key[j] > prefix) { slot = (int)rgt; ++rgt; }
                    else if (key[j] == prefix) { if (req < kneed) slot = (int)(cnt_gt + req); ++req; }
                    so[j] = slot;
                    if (slot >= 0 && (slot >> 8) == half) { gidx[slot & 255] = b * SEQ + 8 * tid + j; gate_l[slot & 255] = __uint_as_float(key[j]); }
                }
                if (half == 0) {
                    *((u32x4*)(slot_of + (size_t)p * SEQ) + 2 * tid) = (u32x4){(unsigned)so[0], (unsigned)so[1], (unsigned)so[2], (unsigned)so[3]};
                    *((u32x4*)(slot_of + (size_t)p * SEQ) + 2 * tid + 1) = (u32x4){(unsigned)so[4], (unsigned)so[5], (unsigned)so[6], (unsigned)so[7]};
                }
                __syncthreads();
            }
            pg8::Gemm g{WSP(bf16_t, WS_XF8), WSP(bf16_t, WS_WGU), DM / 2, DM / 2, DM / 2, 0, (long)2048 * (DM / 2), 0x7A7A7A7A, 0x7F7F7F7F};
            EpiGateUp E{WSP(unsigned char, WS_R1)};
            pg8::gemm_phase<EpiGateUp, true, pg8::PanelOrder, 0, true>(tid, lds, gidx, g, S, E);
        }
        if (IN_PH(P + 7)) { asm volatile("s_waitcnt vmcnt(0)" ::: "memory"); __syncthreads();
            __builtin_amdgcn_fence(__ATOMIC_ACQUIRE, "workgroup");
            __syncthreads(); }
        if (IN_PH(P + 8)) REPS(8) {
            PH_PROLOG
            pg8::PanelOrder S; S.init(bx, 4);
            LAS int* hidx = (LAS int*)(lds + GIDX_OFF + 2048);
            for (int r = tid; r < 256; r += 512) hidx[r] = S.e * EROWS + S.pm * 256 + r;
            __syncthreads();
            pg8::Gemm g{WSP(bf16_t, WS_R1), WSP(bf16_t, WS_WD), FF / 2, FF / 2, FF / 2, 0, (long)DM * (FF / 2), 0x79797979, 0x7F7F7F7F};
            EpiDown E{WSP(unsigned char, WS_R2), (const LAS float*)(lds + GIDX_OFF + 1024)};
            pg8::gemm_phase<EpiDown, true, pg8::PanelOrder, 0, true>(tid, lds, hidx, g, S, E);
        }
        SEAM(P + 8);
        if (IN_PH(P + 9)) REPS(9)
#ifdef PROBE_P9F
        for (int r9_ = 0; r9_ < ((l == DEPTH - 1) ? 2 : 1); ++r9_)
#endif
        {
            PH_PROLOG
            const int cg = 32 * (lane >> 4) + (lane & 15);
            float gg[16], bb[16];
            { const float* g2 = INF(21) + l * DM; const float* b2 = INF(22) + l * DM;
#pragma unroll
              for (int j = 0; j < 2; ++j)
#pragma unroll
                for (int i = 0; i < 8; ++i) { gg[8 * j + i] = g2[8 * (cg + 16 * j) + i]; bb[8 * j + i] = b2[8 * (cg + 16 * j) + i]; } }
            const int* slot_of = WSP(int, WS_SLOT); const unsigned char* slab = WSP(unsigned char, WS_R2); bf16_t* xbf = WSP(bf16_t, WS_XBF);
            const bool final_layer = (l == DEPTH - 1);
            int sl_n; u32x4 raw_n[4][2];
            { const int m0 = gw * 4, b = m0 / SEQ, s0 = m0 % SEQ; sl_n = slot_of[((size_t)b * NE + (lane & 15)) * SEQ + s0 + (lane >> 4)];
#pragma unroll
              for (int t = 0; t < 4; ++t)
#pragma unroll
                  for (int j = 0; j < 2; ++j) raw_n[t][j] = *((const u32x4*)(xbf + (size_t)(m0 + t) * DM) + cg + 16 * j); }
            for (int m0 = gw * 4; m0 < NTOK; m0 += NGW * 4) {
                const int b = m0 / SEQ, s0 = m0 % SEQ;
                const int sl = sl_n;
                u32x4 raw[4][2];
#pragma unroll
                for (int t = 0; t < 4; ++t)
#pragma unroll
                    for (int j = 0; j < 2; ++j) raw[t][j] = raw_n[t][j];
                const unsigned long long bal = __ballot(sl >= 0);
                u32x4 g0[4], g1[4]; unsigned rest[4]; bool h0[4], h1[4];
#pragma unroll
                for (int t = 0; t < 4; ++t) {
                    unsigned mt = (unsigned)(bal >> (16 * t)) & 0xffffu;
                    h0[t] = mt != 0u; const int e0 = h0[t] ? __builtin_ctz(mt) : 0; mt &= mt - 1u;
                    h1[t] = mt != 0u; const int e1 = h1[t] ? __builtin_ctz(mt) : e0; if (h1[t]) mt &= mt - 1u;
                    rest[t] = mt;
                    int s0_ = __builtin_amdgcn_readlane(sl, 16 * t + e0), s1_ = __builtin_amdgcn_readlane(sl, 16 * t + e1);
                    s0_ = s0_ < 0 ? 0 : s0_; s1_ = s1_ < 0 ? 0 : s1_;
                    g0[t] = __builtin_nontemporal_load((const u32x4*)(slab + ((size_t)e0 * EROWS + b * CAP + s0_) * DM) + lane);
                    g1[t] = __builtin_nontemporal_load((const u32x4*)(slab + ((size_t)e1 * EROWS + b * CAP + s1_) * DM) + lane);
                }
                { const int m1 = m0 + NGW * 4;
                  if (m1 < NTOK) { const int b1 = m1 / SEQ, s1 = m1 % SEQ; sl_n = slot_of[((size_t)b1 * NE + (lane & 15)) * SEQ + s1 + (lane >> 4)];
#pragma unroll
                    for (int t = 0; t < 4; ++t)
#pragma unroll
                        for (int j = 0; j < 2; ++j) raw_n[t][j] = *((const u32x4*)(xbf + (size_t)(m1 + t) * DM) + cg + 16 * j); } }
#pragma unroll
                for (int t = 0; t < 4; ++t) {
                    const int m = m0 + t;
                    float v[16]; unpack8(raw[t][0], v); unpack8(raw[t][1], v + 8);
#pragma unroll
                    for (int i = 0; i < 16; ++i) v[i] *= ALPHA;
                    if (h0[t]) acc16_fp8(g0[t], v, 1.0f / 64.0f);
                    if (h1[t]) acc16_fp8(g1[t], v, 1.0f / 64.0f);
                    unsigned mt = rest[t];
                    while (mt) {
                        const int e = __builtin_ctz(mt); mt &= mt - 1u;
                        const int se = __builtin_amdgcn_readlane(sl, 16 * t + e);
                        acc16_fp8(*((const u32x4*)(slab + ((size_t)e * EROWS + b * CAP + se) * DM) + lane), v, 1.0f / 64.0f);
                    }
                    ln_row16(v, gg, bb);
                    if (final_layer) {
#pragma unroll
                        for (int j = 0; j < 2; ++j) { f32x4* o = (f32x4*)(xres + (size_t)m * DM) + 2 * (cg + 16 * j);
                            __builtin_nontemporal_store((f32x4){v[8 * j], v[8 * j + 1], v[8 * j + 2], v[8 * j + 3]}, o); __builtin_nontemporal_store((f32x4){v[8 * j + 4], v[8 * j + 5], v[8 * j + 6], v[8 * j + 7]}, o + 1); } }
                    else { *((u32x4*)(xbf + (size_t)m * DM) + cg) = pack8(v); *((u32x4*)(xbf + (size_t)m * DM) + cg + 16) = pack8(v + 8); }
                }
            }
        }
        if (l + 1 < DEPTH) SEAM(P + 9);
    }
}

extern "C" void kernel_launch(void* const* d_in, const int* in_sizes, int n_in, void* d_out, int out_size, void* d_ws, size_t ws_size, hipStream_t stream) {
    static int grid = 0;
    if (grid == 0) {
        if (n_in != 23 || out_size != NTOK * DM || ws_size < WS_END) { fprintf(stderr, "kernel_launch: unexpected problem (n_in %d out %d ws %zu need %zu)\n", n_in, out_size, ws_size, (size_t)WS_END); grid = -1; return; }
        int dev = 0, cus = 0, per_cu = 0;
        (void)hipGetDevice(&dev);
        (void)hipDeviceGetAttribute(&cus, hipDeviceAttributeMultiprocessorCount, dev);
        (void)hipFuncSetAttribute((const void*)fwd_kernel, hipFuncAttributeMaxDynamicSharedMemorySize, LDS_BYTES);
        (void)hipOccupancyMaxActiveBlocksPerMultiprocessor(&per_cu, (const void*)fwd_kernel, 512, LDS_BYTES);
        (void)hipGetLastError();
        grid = 256;
        if (cus != 256 || per_cu < 1) fprintf(stderr, "kernel_launch: built for a 256-CU device with one resident workgroup per CU (cus %d, per_cu %d)\n", cus, per_cu);
        fprintf(stderr, "kernel_launch: cus %d per_cu %d grid %d ws %zu\n", cus, per_cu, grid, ws_size);
    }
    if (grid < 0) return;
    (void)hipMemsetAsync((char*)d_ws + WS_CTL, 0, 32768, stream);
    Args a{};
    for (int i = 0; i < 23; ++i) a.in[i] = d_in[i];
    a.out = (float*)d_out; a.ws = (unsigned char*)d_ws;
    a.ph_lo = 0; a.ph_hi = DEPTH * NPH;
    void* kargs[] = {&a};
    hipError_t e = hipLaunchCooperativeKernel((const void*)fwd_kernel, dim3(grid), dim3(512), kargs, LDS_BYTES, stream);
    if (e != hipSuccess) fprintf(stderr, "cooperative launch failed: %s (grid %d)\n", hipGetErrorString(e), grid);
}
```
